# Optimizing an MI355X kernel written in HIP

```python
import math
import jax, jax.numpy as jnp
from jax import lax
import numpy as np

D_MODEL = 2048
BATCH = 2
SEQ = 8192
DEPTH = 1

SWA_Q_HEADS = 16
SWA_KV_HEADS = 2
SWA_HEAD_DIM = 64
SWA_WINDOW = 128
GDN_HEADS = 4
GDN_HEAD_DIM = 128
GDN_CONV = 4
GDN_CHUNK = 64
N_MEM = 256
XA_HEADS = 4
XA_HEAD_DIM = 128
D_FF = 4 * D_MODEL
N_BRANCH = 3
RMS_EPS = 1e-6
L2_EPS = 1e-6

SWA_Q_W = SWA_Q_HEADS * SWA_HEAD_DIM
SWA_KV_W = SWA_KV_HEADS * SWA_HEAD_DIM
GDN_W = GDN_HEADS * GDN_HEAD_DIM
XA_W = XA_HEADS * XA_HEAD_DIM
IN_SPLITS = (SWA_Q_W, SWA_KV_W, SWA_KV_W, 3 * GDN_W, GDN_HEADS, GDN_HEADS, GDN_W, XA_W, N_BRANCH * D_MODEL)
IN_WIDTH = sum(IN_SPLITS)

kernel_name = 'hybrid_swa_sink_gdn_memxattn_relu2_block'


def rms_norm(x, g):
    xf = x.astype(jnp.float32)
    y = xf * lax.rsqrt(jnp.mean(xf * xf, axis=-1, keepdims=True) + RMS_EPS)
    return (y * g.astype(jnp.float32)).astype(x.dtype)


def l2_norm(x):
    return x * lax.rsqrt(jnp.sum(x * x, axis=-1, keepdims=True) + L2_EPS)


def split_cols(t, sizes):
    idx, acc = [], 0
    for s in sizes[:-1]:
        acc += s
        idx.append(acc)
    return jnp.split(t, idx, axis=-1)


def sliding_window_attention(q, k, v, sinks):
    B, S, HQ, hd = q.shape
    HKV = k.shape[2]
    G = HQ // HKV
    W = SWA_WINDOW
    nb = S // W
    qb = q.reshape(B, nb, W, HKV, G, hd)
    kb = k.reshape(B, nb, W, HKV, hd)
    vb = v.reshape(B, nb, W, HKV, hd)

    def with_prev(t):
        prev = jnp.pad(t, ((0, 0), (1, 0), (0, 0), (0, 0), (0, 0)))[:, :-1]
        return jnp.concatenate([prev, t], axis=2)

    kc, vc = with_prev(kb), with_prev(vb)
    s = jnp.einsum('bnqhgd,bnkhd->bnhgqk', qb, kc).astype(jnp.float32) * (hd ** -0.5)
    qi = jnp.arange(W)[:, None]
    kj = jnp.arange(2 * W)[None, :]
    band = (kj > qi) & (kj <= qi + W)
    not_pad = (jnp.arange(nb)[:, None, None] > 0) | (kj >= W)[None]
    mask = band[None] & not_pad
    s = jnp.where(mask[None, :, None, None], s, -jnp.inf)
    sk = sinks.astype(jnp.float32).reshape(HKV, G)[None, None, :, :, None, None]
    m = jnp.maximum(jnp.max(s, axis=-1, keepdims=True), sk)
    p = jnp.exp(s - m)
    denom = jnp.sum(p, axis=-1, keepdims=True) + jnp.exp(sk - m)
    pr = (p / denom).astype(v.dtype)
    o = jnp.einsum('bnhgqk,bnkhd->bnqhgd', pr, vc)
    return o.reshape(B, S, HQ * hd)


def causal_depthwise_conv(x, w):
    K, C = w.shape
    return lax.conv_general_dilated(
        x, w.reshape(K, 1, C), window_strides=(1,), padding=[(K - 1, 0)],
        dimension_numbers=('NWC', 'WIO', 'NWC'), feature_group_count=C)


def chunked_gated_delta_rule(q, k, v, g, beta):
    B, S, H, dk = q.shape
    dv = v.shape[-1]
    C = GDN_CHUNK
    N = S // C

    def to_chunks(t):
        return t.reshape(B, N, C, H, -1).transpose(1, 0, 3, 2, 4)

    qc, kc, vc = to_chunks(q), to_chunks(k), to_chunks(v)
    gc = g.reshape(B, N, C, H).transpose(1, 0, 3, 2)
    bc = beta.reshape(B, N, C, H).transpose(1, 0, 3, 2)
    gcum = jnp.cumsum(gc, axis=-1)
    causal = jnp.tril(jnp.ones((C, C), dtype=bool))
    strict = jnp.tril(jnp.ones((C, C), dtype=bool), k=-1)
    decay = jnp.exp(jnp.where(causal, gcum[..., :, None] - gcum[..., None, :], -jnp.inf))
    kk = jnp.einsum('nbhcd,nbhed->nbhce', kc, kc)
    lower = jnp.where(strict, bc[..., :, None] * kk * decay, 0.0)
    a_mat = jnp.eye(C, dtype=q.dtype) + lower
    rhs = jnp.concatenate([vc * bc[..., None], kc * (bc * jnp.exp(gcum))[..., None]], axis=-1)
    sol = lax.linalg.triangular_solve(a_mat, rhs, left_side=True, lower=True, unit_diagonal=True)
    u, w = sol[..., :dv], sol[..., dv:]
    qk = jnp.einsum('nbhcd,nbhed->nbhce', qc, kc) * decay
    q_dec = qc * jnp.exp(gcum)[..., None]
    k_dec = kc * jnp.exp(gcum[..., -1:] - gcum)[..., None]
    g_last = jnp.exp(gcum[..., -1])

    def step(state, inp):
        qk_i, qd_i, kd_i, u_i, w_i, gl_i = inp
        v_new = u_i - jnp.einsum('bhcd,bhde->bhce', w_i, state)
        o = jnp.einsum('bhcd,bhde->bhce', qd_i, state) + jnp.einsum('bhce,bhef->bhcf', qk_i, v_new)
        state = state * gl_i[..., None, None] + jnp.einsum('bhcd,bhce->bhde', kd_i, v_new)
        return state, o

    state0 = jnp.zeros((B, H, dk, dv), dtype=q.dtype)
    _, o = lax.scan(step, state0, (qk, q_dec, k_dec, u, w, g_last))
    return o.transpose(1, 0, 3, 2, 4).reshape(B, S, H, dv)


def gated_deltanet(qkv, a, b, z, conv_w, a_log, dt_bias, norm_w):
    B, S, _ = qkv.shape
    H, dh = GDN_HEADS, GDN_HEAD_DIM
    f32 = jnp.float32
    qkv = jax.nn.silu(causal_depthwise_conv(qkv, conv_w))
    q, k, v = jnp.split(qkv, 3, axis=-1)
    q = l2_norm(q.reshape(B, S, H, dh).astype(f32)) * (dh ** -0.5)
    k = l2_norm(k.reshape(B, S, H, dh).astype(f32))
    v = v.reshape(B, S, H, dh).astype(f32)
    beta = jax.nn.sigmoid(b.astype(f32))
    g = -jnp.exp(a_log.astype(f32)) * jax.nn.softplus(a.astype(f32) + dt_bias.astype(f32))
    o = chunked_gated_delta_rule(q, k, v, g, beta)
    o = rms_norm(o, norm_w) * jax.nn.silu(z.reshape(B, S, H, dh).astype(f32))
    return o.reshape(B, S, H * dh).astype(qkv.dtype)


def memory_cross_attention(q, mkv):
    B, S, _ = q.shape
    q = q.reshape(B, S, XA_HEADS, XA_HEAD_DIM)
    mk, mv = jnp.split(mkv, 2, axis=-1)
    mk = mk.reshape(B, N_MEM, XA_HEADS, XA_HEAD_DIM)
    mv = mv.reshape(B, N_MEM, XA_HEADS, XA_HEAD_DIM)
    s = jnp.einsum('bshd,bmhd->bhsm', q, mk).astype(jnp.float32) * (XA_HEAD_DIM ** -0.5)
    p = jax.nn.softmax(s, axis=-1).astype(mv.dtype)
    return jnp.einsum('bhsm,bmhd->bshd', p, mv).reshape(B, S, XA_W)


def setup_inputs(seed: int = 0) -> dict:
    key = jax.random.key(seed)
    ks = jax.random.split(key, 20)
    f32 = jnp.float32
    L, D = DEPTH, D_MODEL

    def nrm(k, shape, scale):
        return jax.random.normal(k, shape, f32) * scale

    x = nrm(ks[0], (BATCH, SEQ, D), 1.0)
    mem = nrm(ks[1], (BATCH, N_MEM, D), 1.0)
    g_mix = 1.0 + nrm(ks[2], (L, D), 0.02)
    w_in = nrm(ks[3], (L, D, IN_WIDTH), D ** -0.5)
    sinks = nrm(ks[4], (L, SWA_Q_HEADS), 0.5)
    conv_w = nrm(ks[5], (L, GDN_CONV, 3 * GDN_W), GDN_CONV ** -0.5)
    a_log = jnp.log(jax.random.uniform(ks[6], (L, GDN_HEADS), f32, 1.0, 16.0))
    dt = jnp.exp(jax.random.uniform(ks[7], (L, GDN_HEADS), f32, math.log(1e-3), math.log(1e-1)))
    dt_bias = dt + jnp.log(-jnp.expm1(-dt))
    gdn_norm_w = 1.0 + nrm(ks[8], (L, GDN_HEAD_DIM), 0.02)
    g_mem = 1.0 + nrm(ks[9], (L, D), 0.02)
    w_mem_kv = nrm(ks[10], (L, D, 2 * XA_W), D ** -0.5)
    w_swa_up = nrm(ks[11], (L, SWA_Q_W, D), SWA_Q_W ** -0.5)
    w_gdn_up = nrm(ks[12], (L, GDN_W, D), GDN_W ** -0.5)
    w_xa_up = nrm(ks[13], (L, XA_W, D), XA_W ** -0.5)
    w_out = nrm(ks[14], (L, D, D), D ** -0.5)
    g_mlp = 1.0 + nrm(ks[15], (L, D), 0.02)
    w_mlp_in = nrm(ks[16], (L, D, D_FF), D ** -0.5)
    w_mlp_out = nrm(ks[17], (L, D_FF, D), D_FF ** -0.5)
    g_final = 1.0 + nrm(ks[18], (D,), 0.02)
    return {'x': x, 'mem': mem, 'g_mix': g_mix, 'w_in': w_in, 'sinks': sinks, 'conv_w': conv_w,
            'a_log': a_log, 'dt_bias': dt_bias, 'gdn_norm_w': gdn_norm_w, 'g_mem': g_mem,
            'w_mem_kv': w_mem_kv, 'w_swa_up': w_swa_up, 'w_gdn_up': w_gdn_up, 'w_xa_up': w_xa_up,
            'w_out': w_out, 'g_mlp': g_mlp, 'w_mlp_in': w_mlp_in, 'w_mlp_out': w_mlp_out,
            'g_final': g_final}


def reference(x, mem, g_mix, w_in, sinks, conv_w, a_log, dt_bias, gdn_norm_w, g_mem, w_mem_kv,
              w_swa_up, w_gdn_up, w_xa_up, w_out, g_mlp, w_mlp_in, w_mlp_out, g_final):
    B, S, D = x.shape
    h = x
    for l in range(DEPTH):
        n = rms_norm(h, g_mix[l])
        p = n @ w_in[l]
        q_a, k_a, v_a, qkv_b, a_b, b_b, z_b, q_c, gate_logits = split_cols(p, IN_SPLITS)
        y_a = sliding_window_attention(
            q_a.reshape(B, S, SWA_Q_HEADS, SWA_HEAD_DIM),
            k_a.reshape(B, S, SWA_KV_HEADS, SWA_HEAD_DIM),
            v_a.reshape(B, S, SWA_KV_HEADS, SWA_HEAD_DIM), sinks[l])
        y_b = gated_deltanet(qkv_b, a_b, b_b, z_b, conv_w[l], a_log[l], dt_bias[l], gdn_norm_w[l])
        mkv = rms_norm(mem, g_mem[l]) @ w_mem_kv[l]
        y_c = memory_cross_attention(q_c, mkv)
        g_a, g_b, g_c = jnp.split(jax.nn.sigmoid(gate_logits), N_BRANCH, axis=-1)
        merged = g_a * (y_a @ w_swa_up[l]) + g_b * (y_b @ w_gdn_up[l]) + g_c * (y_c @ w_xa_up[l])
        h = h + merged @ w_out[l]
        u = rms_norm(h, g_mlp[l]) @ w_mlp_in[l]
        h = h + jnp.square(jax.nn.relu(u)) @ w_mlp_out[l]
    return rms_norm(h, g_final)
```

```cpp
#include <hip/hip_runtime.h>
#include <hip/hip_cooperative_groups.h>
#include <cstdio>
#include <cstdint>
#include <cmath>
namespace pg8 {
#define PG8_LAS __attribute__((address_space(3)))
typedef unsigned short bf16_t;
typedef short bf16x8 __attribute__((ext_vector_type(8)));
typedef float f32x4 __attribute__((ext_vector_type(4)));
typedef unsigned u32x4 __attribute__((ext_vector_type(4)));
constexpr int BM = 256, BK = 64, HALF = 128, HTB = HALF * BK * 2  , STAGE_BYTES = 8 * HTB, NXCD = 8, WGM = 8;

__host__ __device__ __forceinline__ int lds_byte(int r, int c) { const int st = (r >> 4) * 2 + (c >> 5), rr = r & 15, cc = c & 31, ob = rr * 64 + cc * 2; return st * 1024 + (ob ^ (((ob >> 9) & 1) << 5)); }
__host__ __device__ __forceinline__ void stage_rc(int b, int& R, int& C) { const int st = b / 1024, sb = b % 1024, swz = sb ^ (((sb >> 9) & 1) << 5); R = (st >> 1) * 16 + swz / 64; C = (st & 1) * 32 + (swz % 64) / 2; }
__host__ __device__ __forceinline__ int perm32(int rho) { const int n = rho >> 4, i = rho & 15; return 8 * (i >> 2) + 4 * n + (i & 3); }

struct Unit { int pm, pn; };
struct Gemm { const bf16_t* A; const bf16_t* Bt; int M, N, K; };

struct StaticOrder {
    int nM, nN, nwg, G, c;
    __host__ __device__ void init(int M, int N, int G_, int c_) { nM = M / BM; nN = N / BM; nwg = nM * nN; G = G_; c = c_; }
    __host__ __device__ bool next(int i, Unit& u) const {
        const long L = (long)i * G + c; if (L >= nwg) return false;
        int wgid = (int)L; { const int q = nwg / NXCD, r = nwg % NXCD, xcd = wgid % NXCD, off = wgid / NXCD; wgid = (xcd < r ? xcd * (q + 1) : r * (q + 1) + (xcd - r) * q) + off; }
        const int nig = WGM * nN, gid = wgid / nig, fm = gid * WGM, gsz = (nM - fm) < WGM ? (nM - fm) : WGM;
        u.pm = fm + ((wgid % nig) % gsz); u.pn = (wgid % nig) / gsz; return true;
    }
    __device__ __forceinline__ void a_ready(const Unit&) const {}
    __device__ __forceinline__ void done(const Unit&) const {}
};

typedef float f32x2c_t __attribute__((ext_vector_type(2))); typedef __bf16 bf16x2c_t __attribute__((ext_vector_type(2)));
__device__ __forceinline__ unsigned cvt_pk_bf16(float lo, float hi) { const f32x2c_t v = {lo, hi}; const bf16x2c_t b = __builtin_convertvector(v, bf16x2c_t); return __builtin_bit_cast(unsigned, b); }
typedef float f32x2 __attribute__((ext_vector_type(2)));
typedef unsigned u32x2 __attribute__((ext_vector_type(2)));
__device__ __forceinline__ float bf_lo(unsigned w) { return __uint_as_float(w << 16); }
__device__ __forceinline__ float bf_hi(unsigned w) { return __uint_as_float(w & 0xffff0000u); }
struct EpiStore {
    static constexpr bool PERM = true, AFTER_DRAIN = false;
    bf16_t* O; int ldc;
    __device__ __forceinline__ void operator()(const f32x4 (&acc)[2][2][4][2], const Unit& u, int wr, int wc, int fr, int fq) const {
        const int row0 = u.pm * BM + wr * 64 + fr, col0 = u.pn * BM + wc * 32 + 8 * fq;
#pragma unroll
        for (int ai = 0; ai < 2; ++ai)
#pragma unroll
            for (int m = 0; m < 4; ++m) { bf16_t* rowp = O + (size_t)(row0 + ai * HALF + m * 16) * ldc + col0;
#pragma unroll
                for (int bj = 0; bj < 2; ++bj) { const f32x4 v0 = acc[ai][bj][m][0], v1 = acc[ai][bj][m][1];
                    u32x4 w; w.x = cvt_pk_bf16(v0[0], v0[1]); w.y = cvt_pk_bf16(v0[2], v0[3]); w.z = cvt_pk_bf16(v1[0], v1[1]); w.w = cvt_pk_bf16(v1[2], v1[3]);
                    *(u32x4*)(rowp + bj * HALF) = w; } }
    }
};
struct EpiGate {
    static constexpr bool PERM = true, AFTER_DRAIN = false;
    const bf16_t* gate; int ldg; bf16_t* mg; int ldm; int first;
    __device__ __forceinline__ void operator()(const f32x4 (&acc)[2][2][4][2], const Unit& u, int wr, int wc, int fr, int fq) const {
        const int row0 = u.pm * BM + wr * 64 + fr, col0 = u.pn * BM + wc * 32 + 8 * fq;
#pragma unroll
        for (int ai = 0; ai < 2; ++ai)
#pragma unroll
            for (int m = 0; m < 4; ++m) { const size_t row = (size_t)(row0 + ai * HALF + m * 16);
#pragma unroll
                for (int bj = 0; bj < 2; ++bj) { const int col = col0 + bj * HALF;
                    const u32x4 gw = *(const u32x4*)(gate + row * ldg + col);
                    const f32x4 v0 = acc[ai][bj][m][0], v1 = acc[ai][bj][m][1];
                    float g[8] = {bf_lo(gw.x), bf_hi(gw.x), bf_lo(gw.y), bf_hi(gw.y), bf_lo(gw.z), bf_hi(gw.z), bf_lo(gw.w), bf_hi(gw.w)};
                    float r[8] = {v0[0], v0[1], v0[2], v0[3], v1[0], v1[1], v1[2], v1[3]};
#pragma unroll
                    for (int e = 0; e < 8; ++e) r[e] *= __builtin_amdgcn_rcpf(1.0f + __expf(-g[e]));
                    bf16_t* mp = mg + row * ldm + col;
                    if (!first) { const u32x4 ow = *(const u32x4*)mp;
                        r[0] += bf_lo(ow.x); r[1] += bf_hi(ow.x); r[2] += bf_lo(ow.y); r[3] += bf_hi(ow.y); r[4] += bf_lo(ow.z); r[5] += bf_hi(ow.z); r[6] += bf_lo(ow.w); r[7] += bf_hi(ow.w); }
                    u32x4 w; w.x = cvt_pk_bf16(r[0], r[1]); w.y = cvt_pk_bf16(r[2], r[3]); w.z = cvt_pk_bf16(r[4], r[5]); w.w = cvt_pk_bf16(r[6], r[7]);
                    *(u32x4*)mp = w; } }
    }
};
struct EpiResid {
    static constexpr bool PERM = false, AFTER_DRAIN = false;
    const float* base; const bf16_t* baseb; float* out; bf16_t* ob; float* ssq; int ldc;
    __device__ __forceinline__ void operator()(const f32x4 (&acc)[2][2][4][2], const Unit& u, int wr, int wc, int fr, int fq) const {
        const int col0 = u.pn * BM + wc * 32 + 4 * fq;
#pragma unroll
        for (int ai = 0; ai < 2; ++ai)
#pragma unroll
            for (int m = 0; m < 4; ++m) { const int row = u.pm * BM + ai * HALF + wr * 64 + m * 16 + fr; const size_t off = (size_t)row * ldc + col0; float s = 0.f;
#pragma unroll
                for (int bj = 0; bj < 2; ++bj)
#pragma unroll
                    for (int n = 0; n < 2; ++n) { const size_t o2 = off + bj * HALF + n * 16;
                        f32x4 b;
                        if (baseb) { const u32x2 w = *(const u32x2*)(baseb + o2); b = (f32x4){bf_lo(w.x), bf_hi(w.x), bf_lo(w.y), bf_hi(w.y)}; } else b = *(const f32x4*)(base + o2);
                        const f32x4 o = b + acc[ai][bj][m][n];
                        if (out) *(f32x4*)(out + o2) = o;
                        s += (o[0] * o[0] + o[1] * o[1]) + (o[2] * o[2] + o[3] * o[3]);
                        if (ob) { u32x2 w; w.x = cvt_pk_bf16(o[0], o[1]); w.y = cvt_pk_bf16(o[2], o[3]); *(u32x2*)(ob + o2) = w; } }
                s += __shfl_xor(s, 16); s += __shfl_xor(s, 32);
                if (fq == 0) unsafeAtomicAdd(ssq + row, s); }
    }
};
struct EpiRelu2 {
    static constexpr bool PERM = true, AFTER_DRAIN = false;
    bf16_t* O; int ldc; const float* ssq; float inv_n, eps;
    __device__ __forceinline__ void operator()(const f32x4 (&acc)[2][2][4][2], const Unit& u, int wr, int wc, int fr, int fq) const {
        const int row0 = u.pm * BM + wr * 64 + fr, col0 = u.pn * BM + wc * 32 + 8 * fq;
#pragma unroll
        for (int ai = 0; ai < 2; ++ai)
#pragma unroll
            for (int m = 0; m < 4; ++m) { const int row = row0 + ai * HALF + m * 16; const float rs = rsqrtf(ssq[row] * inv_n + eps); bf16_t* rowp = O + (size_t)row * ldc + col0;
#pragma unroll
                for (int bj = 0; bj < 2; ++bj) { f32x4 v0 = acc[ai][bj][m][0] * rs, v1 = acc[ai][bj][m][1] * rs;
#pragma unroll
                    for (int e = 0; e < 4; ++e) { v0[e] = fmaxf(v0[e], 0.f); v0[e] *= v0[e]; v1[e] = fmaxf(v1[e], 0.f); v1[e] *= v1[e]; }
                    u32x4 w; w.x = cvt_pk_bf16(v0[0], v0[1]); w.y = cvt_pk_bf16(v0[2], v0[3]); w.z = cvt_pk_bf16(v1[0], v1[1]); w.w = cvt_pk_bf16(v1[2], v1[3]);
                    *(u32x4*)(rowp + bj * HALF) = w; } }
    }
};
template <class Epi, class Sched, bool ALIGN_EPI = false, bool SP2 = false>
__device__ __forceinline__ void gemm_phase(PG8_LAS unsigned char* lds, const Gemm g, const Sched& S, const Epi& E) {
    int tid_raw_ = threadIdx.x; asm volatile("" : "+v"(tid_raw_));
    const int tid = tid_raw_, wid = __builtin_amdgcn_readfirstlane(tid >> 6), lane = tid & 63, wr = wid >> 2, wc = wid & 3, fr = lane & 15, fq = lane >> 4;
    const int K = g.K, nt = K / BK;
    unsigned voffA[2], voffB[2];
#pragma unroll
    for (int i = 0; i < 2; ++i) { int R, C; stage_rc(tid * 16 + i * 8192, R, C); const int Rb = Epi::PERM ? ((R & ~31) + perm32(R & 31)) : R;
        voffA[i] = (unsigned)(R * K + C) * 2u; voffB[i] = (unsigned)(Rb * K + C) * 2u; }
    const size_t kstep = (size_t)(BK * 2);
    const size_t hstep = (size_t)HALF * K * 2;
    const size_t tstep = 2 * hstep;
    const unsigned ldsw = (unsigned)wid * 1024u;
    const int aoff = lds_byte(wr * 64 + fr, fq * 8), boff = lds_byte(wc * 32 + fr, fq * 8);
#define PG8_SA(b, h) (((b) * 2 + (h)) * HTB)
#define PG8_SB(b, h) ((4 + (b) * 2 + (h)) * HTB)
#define PG8_STAGE(bufoff, gbase, voff) do { _Pragma("unroll") for (int _i = 0; _i < 2; ++_i) \
        __builtin_amdgcn_global_load_lds((const unsigned*)((const char*)(gbase) + (voff)[_i]), (PG8_LAS unsigned*)(lds + (bufoff) + ldsw + _i * 8192), 16, 0, 0); } while (0)
#define PG8_LDA(dst, b, h) do { _Pragma("unroll") for (int m = 0; m < 4; ++m) _Pragma("unroll") for (int k = 0; k < 2; ++k) dst[m][k] = *(const PG8_LAS bf16x8*)(lds + PG8_SA(b, h) + aoff + m * 2048 + k * 1024); } while (0)
#define PG8_LDB(dst, b, h) do { _Pragma("unroll") for (int n = 0; n < 2; ++n) _Pragma("unroll") for (int k = 0; k < 2; ++k) dst[n][k] = *(const PG8_LAS bf16x8*)(lds + PG8_SB(b, h) + boff + n * 2048 + k * 1024); } while (0)
#define PG8_MMA(ai, bj, At, Bt) do { __builtin_amdgcn_s_setprio(1); _Pragma("unroll") for (int m = 0; m < 4; ++m) _Pragma("unroll") for (int n = 0; n < 2; ++n) _Pragma("unroll") for (int k = 0; k < 2; ++k) \
        acc[ai][bj][m][n] = __builtin_amdgcn_mfma_f32_16x16x32_bf16(Bt[n][k], At[m][k], acc[ai][bj][m][n], 0, 0, 0); __builtin_amdgcn_s_setprio(0); } while (0)
#define PG8_WAIT_V(n) asm volatile("s_waitcnt vmcnt(" #n ")" ::: "memory")
#define PG8_WAIT_L(n) asm volatile("s_waitcnt lgkmcnt(" #n ")" ::: "memory")
#define PG8_BAR __builtin_amdgcn_s_barrier()
#define PG8_SCHED __builtin_amdgcn_sched_barrier(0)
    Unit cur, nxt; int ui = 0;
    if (!S.next(0, cur)) return;
    f32x4 acc[2][2][4][2];
#pragma unroll
    for (int a = 0; a < 2; ++a)
#pragma unroll
        for (int b = 0; b < 2; ++b)
#pragma unroll
            for (int m = 0; m < 4; ++m)
#pragma unroll
                for (int n = 0; n < 2; ++n) acc[a][b][m][n] = (f32x4){0.f, 0.f, 0.f, 0.f};
    bf16x8 At[4][2], B0[2][2], B1[2][2];
    const char* cA = (const char*)g.A + (size_t)cur.pm * tstep; const char* cB = (const char*)g.Bt + (size_t)cur.pn * tstep;
    S.a_ready(cur);
    if constexpr (SP2) {
        PG8_STAGE(PG8_SB(0, 0), cB, voffB); PG8_STAGE(PG8_SB(0, 1), cB + hstep, voffB); PG8_STAGE(PG8_SA(0, 0), cA, voffA); PG8_STAGE(PG8_SA(0, 1), cA + hstep, voffA);
        if (wr == 1) PG8_BAR;
        PG8_WAIT_V(2); PG8_BAR;
        PG8_STAGE(PG8_SB(1, 0), cB + kstep, voffB); PG8_STAGE(PG8_SA(1, 0), cA + kstep, voffA); PG8_STAGE(PG8_SB(1, 1), cB + hstep + kstep, voffB);
        PG8_WAIT_V(6); PG8_BAR;
    } else {
        PG8_STAGE(PG8_SB(0, 0), cB, voffB); PG8_STAGE(PG8_SA(0, 0), cA, voffA); PG8_STAGE(PG8_SB(0, 1), cB + hstep, voffB); PG8_STAGE(PG8_SA(0, 1), cA + hstep, voffA);
        if (wr == 1) PG8_BAR;
        PG8_WAIT_V(4); PG8_BAR;
        PG8_STAGE(PG8_SB(1, 0), cB + kstep, voffB); PG8_STAGE(PG8_SA(1, 0), cA + kstep, voffA); PG8_STAGE(PG8_SB(1, 1), cB + hstep + kstep, voffB);
        PG8_WAIT_V(6); PG8_BAR;
    }
    for (;;) {
        const bool has_next = S.next(ui + 1, nxt);
        const char* nA = has_next ? (const char*)g.A + (size_t)nxt.pm * tstep : cA; const char* nB = has_next ? (const char*)g.Bt + (size_t)nxt.pn * tstep : cB;
        for (int t = 0; t < nt; t += 2) {
            const bool last = (t == nt - 2);
            const char* a1 = cA + (size_t)(t + 1) * kstep;
            const char* a2 = last ? nA : cA + (size_t)(t + 2) * kstep; const char* b2 = last ? nB : cB + (size_t)(t + 2) * kstep;
            const char* a3 = a2 + kstep; const char* b3 = b2 + kstep;
            if (last && has_next) S.a_ready(nxt);
            if constexpr (SP2) {
            PG8_LDB(B0, 0, 0); PG8_LDB(B1, 0, 1); PG8_SCHED; PG8_LDA(At, 0, 0); PG8_STAGE(PG8_SA(1, 1), a1 + hstep, voffA);
            PG8_WAIT_V(8); PG8_WAIT_L(0); PG8_BAR; PG8_MMA(0, 0, At, B0); PG8_MMA(0, 1, At, B1); PG8_BAR; PG8_SCHED;
            PG8_LDA(At, 0, 1); PG8_STAGE(PG8_SB(0, 0), b2, voffB); PG8_STAGE(PG8_SB(0, 1), b2 + hstep, voffB); PG8_STAGE(PG8_SA(0, 0), a2, voffA);
            PG8_WAIT_V(8); PG8_WAIT_L(0); PG8_BAR; PG8_MMA(1, 0, At, B0); PG8_MMA(1, 1, At, B1); PG8_BAR; PG8_SCHED;
            PG8_LDB(B0, 1, 0); PG8_LDB(B1, 1, 1); PG8_SCHED; PG8_LDA(At, 1, 0); PG8_STAGE(PG8_SA(0, 1), a2 + hstep, voffA);
            PG8_WAIT_V(8); PG8_WAIT_L(0); PG8_BAR; PG8_MMA(0, 0, At, B0); PG8_MMA(0, 1, At, B1); PG8_BAR; PG8_SCHED;
            PG8_LDA(At, 1, 1); PG8_STAGE(PG8_SB(1, 0), b3, voffB); PG8_STAGE(PG8_SB(1, 1), b3 + hstep, voffB); PG8_STAGE(PG8_SA(1, 0), a3, voffA);
            PG8_WAIT_V(8); PG8_WAIT_L(0); PG8_BAR; PG8_MMA(1, 0, At, B0); PG8_MMA(1, 1, At, B1); PG8_BAR; PG8_SCHED;
            } else {
            PG8_LDB(B0, 0, 0); PG8_SCHED; PG8_LDA(At, 0, 0); PG8_STAGE(PG8_SA(1, 1), a1 + hstep, voffA);
            PG8_WAIT_L(8); PG8_BAR; PG8_WAIT_L(0); PG8_MMA(0, 0, At, B0); PG8_BAR; PG8_SCHED;
            PG8_LDB(B1, 0, 1); PG8_STAGE(PG8_SB(0, 0), b2, voffB);
            PG8_BAR; PG8_WAIT_L(0); PG8_MMA(0, 1, At, B1); PG8_BAR;
            PG8_LDA(At, 0, 1); PG8_STAGE(PG8_SA(0, 0), a2, voffA);
            PG8_BAR; PG8_WAIT_L(0); PG8_MMA(1, 0, At, B0); PG8_BAR; PG8_SCHED;
            PG8_STAGE(PG8_SB(0, 1), b2 + hstep, voffB);
            PG8_WAIT_V(6); PG8_BAR; PG8_MMA(1, 1, At, B1); PG8_BAR;
            PG8_LDB(B0, 1, 0); PG8_SCHED; PG8_LDA(At, 1, 0); PG8_STAGE(PG8_SA(0, 1), a2 + hstep, voffA);
            PG8_WAIT_L(8); PG8_BAR; PG8_WAIT_L(0); PG8_MMA(0, 0, At, B0); PG8_BAR; PG8_SCHED;
            PG8_LDB(B1, 1, 1); PG8_STAGE(PG8_SB(1, 0), b3, voffB);
            PG8_BAR; PG8_WAIT_L(0); PG8_MMA(0, 1, At, B1); PG8_BAR;
            PG8_LDA(At, 1, 1); PG8_STAGE(PG8_SA(1, 0), a3, voffA);
            PG8_BAR; PG8_WAIT_L(0); PG8_MMA(1, 0, At, B0); PG8_BAR; PG8_SCHED;
            PG8_STAGE(PG8_SB(1, 1), b3 + hstep, voffB);
            PG8_WAIT_V(6); PG8_BAR; PG8_MMA(1, 1, At, B1); PG8_BAR;
            }
        }
        if constexpr (ALIGN_EPI) { if (wr == 0) PG8_BAR; }
        if constexpr (!Epi::AFTER_DRAIN) { E(acc, cur, wr, wc, fr, fq); S.done(cur); }
        if (!has_next) break;
#pragma unroll
        for (int a = 0; a < 2; ++a)
#pragma unroll
            for (int b = 0; b < 2; ++b)
#pragma unroll
                for (int m = 0; m < 4; ++m)
#pragma unroll
                    for (int n = 0; n < 2; ++n) acc[a][b][m][n] = (f32x4){0.f, 0.f, 0.f, 0.f};
        cur = nxt; cA = nA; cB = nB; ++ui;
        if constexpr (ALIGN_EPI) { if (wr == 1) PG8_BAR; }
    }
    PG8_WAIT_V(0);
    if constexpr (!ALIGN_EPI) { if (wr == 0) PG8_BAR; }
    PG8_BAR;
    if constexpr (Epi::AFTER_DRAIN) { E.fused(acc, cur, wr, wc, fr, fq, lds, wid, lane); S.done(cur); }
#undef PG8_SA
#undef PG8_SB
#undef PG8_STAGE
#undef PG8_LDA
#undef PG8_LDB
#undef PG8_MMA
#undef PG8_WAIT_V
#undef PG8_WAIT_L
#undef PG8_BAR
#undef PG8_SCHED
}
}
#ifndef PG8_SP2
#define PG8_SP2 true
#endif
#define REP_P2 1
#define REP_SCAN 1
#define REP_P0 1
#ifndef PG8_ALIGN
#define PG8_ALIGN true
#endif
constexpr int BATCH = 2, SEQ = 8192, DM = 2048, MTOK = BATCH * SEQ, NMEM = 256, DFF = 8192;
constexpr int INW = 9992, N1 = 9984;
constexpr int C_QKVB = 0, C_ZB = 1536, C_QA = 2048, C_KA = 3072, C_VA = 3200, C_QC = 3328, C_GATE = 3840;
constexpr int O_AB = 2816;
constexpr float RMS_EPS = 1e-6f;
constexpr size_t MiB = 1u << 20;
constexpr size_t WS_CNT = 720896;
constexpr size_t WS_SSQ1 = 0, WS_SSQ2 = 65536, WS_AB = 131072, WS_GL = 655360, WS_MKV = 1 * MiB, WS_MEMN = 2 * MiB;
constexpr size_t WS_WINT = 4 * MiB, WS_WMKVT = 43 * MiB, WS_WSWAT = 47 * MiB, WS_WGDNT = 51 * MiB, WS_WXAT = 53 * MiB, WS_WOUTT = 55 * MiB;
constexpr size_t WS_P = 64 * MiB;
constexpr size_t WS_MERGED = 448 * MiB, WS_HB = 64 * MiB, WS_END = 512 * MiB;
constexpr size_t WS_GW = 376 * MiB, WS_GQD = 392 * MiB, WS_GKDT = 408 * MiB, WS_GQK = 424 * MiB, WS_GU = 432 * MiB;
constexpr size_t WS_W1T = 4 * MiB;
constexpr int NA = 2048;
constexpr size_t WS_HMID = 128 * MiB, WS_W2T = 384 * MiB;
constexpr int LDS_BYTES = 147456;

#define LAS __attribute__((address_space(3)))
typedef unsigned short bf16;
typedef short h8 __attribute__((ext_vector_type(8)));
typedef float v4f __attribute__((ext_vector_type(4)));
typedef float v16f __attribute__((ext_vector_type(16)));
typedef unsigned v4u __attribute__((ext_vector_type(4)));
typedef unsigned v2u __attribute__((ext_vector_type(2)));
#define MFMA32(a, b, c) __builtin_amdgcn_mfma_f32_32x32x16_bf16((a), (b), (c), 0, 0, 0)
__device__ __forceinline__ unsigned pk2(float lo, float hi) { return pg8::cvt_pk_bf16(lo, hi); }
__device__ __forceinline__ bf16 f2bf(float f) { return (bf16)(pk2(f, 0.f) & 0xffffu); }
__device__ __forceinline__ float bflo(unsigned w) { return __uint_as_float(w << 16); }
__device__ __forceinline__ float bfhi(unsigned w) { return __uint_as_float(w & 0xffff0000u); }
__device__ __forceinline__ int swap23(int p) { return (p & ~12) | ((p & 4) << 1) | ((p & 8) >> 1); }
__device__ __forceinline__ int crow(int r, int hi) { return (r & 3) + 8 * (r >> 2) + 4 * hi; }
__device__ __forceinline__ float wave_sum(float v) {
#pragma unroll
    for (int o = 1; o < 64; o <<= 1) v += __shfl_xor(v, o);
    return v;
}
#define LDS_BARRIER() asm volatile("s_waitcnt lgkmcnt(0)\n\ts_barrier" ::: "memory")
__device__ __forceinline__ float sigmoidf_(float x) { return __builtin_amdgcn_rcpf(1.0f + __expf(-x)); }

__device__ __forceinline__ void tr_load(float (&v)[32], const float* W, int ldw, int col0src, int kb, int nb, int lane) {
    const int k0 = 64 * kb, n0 = 32 * nb;
#pragma unroll
    for (int i = 0; i < 32; ++i) v[i] = W[(size_t)(k0 + 2 * i + (lane >> 5)) * ldw + col0src + n0 + (lane & 31)];
}
__device__ __forceinline__ void tr_store(const float (&v)[32], const float* kscale, int K, bf16* WT, LAS float* scr, int kb, int nb, int lane) {
    const int k0 = 64 * kb, n0 = 32 * nb;
#pragma unroll
    for (int i = 0; i < 32; ++i) { const int kk = 2 * i + (lane >> 5); float x = v[i]; if (kscale) x *= kscale[k0 + kk]; scr[kk * 33 + (lane & 31)] = x; }
    asm volatile("s_waitcnt lgkmcnt(0)" ::: "memory");
    const int c = lane & 7;
#pragma unroll
    for (int j = 0; j < 4; ++j) { const int n = (lane >> 3) + 8 * j; const LAS float* sp = scr + (8 * c) * 33 + n;
        v4u o; o.x = pk2(sp[0 * 33], sp[1 * 33]); o.y = pk2(sp[2 * 33], sp[3 * 33]); o.z = pk2(sp[4 * 33], sp[5 * 33]); o.w = pk2(sp[6 * 33], sp[7 * 33]);
        *(v4u*)(WT + (size_t)(n0 + n) * K + k0 + 8 * c) = o; }
    asm volatile("s_waitcnt lgkmcnt(0)" ::: "memory");
}
__device__ __forceinline__ int win_csrc(bool skip_ab, int nb) { if (!skip_ab) return 0; const int c0 = nb * 32; return (c0 < 1536) ? 1280 : (c0 < 2048) ? (2824 - 1536) : (c0 < 3328) ? -2048 : 8; }
__device__ __forceinline__ void transpose_matrix(const float* W, int ldw, int K, int N, bool skip_ab, const float* kscale, bf16* WT, LAS float* scr, int gw, int NGW, int& off, int lane) {
    const int nblk = N / 32, items = (K / 64) * nblk;
    int start = (gw - (off % NGW)); if (start < 0) start += NGW;
    off += items;
    if (start >= items) return;
    float va[32], vb[32];
    tr_load(va, W, ldw, win_csrc(skip_ab, start % nblk), start / nblk, start % nblk, lane);
    for (int it = start; it < items; it += 2 * NGW) {
        const int it1 = it + NGW, it2 = it + 2 * NGW;
        if (it1 < items) tr_load(vb, W, ldw, win_csrc(skip_ab, it1 % nblk), it1 / nblk, it1 % nblk, lane);
        tr_store(va, kscale, K, WT, scr, it / nblk, it % nblk, lane);
        if (it1 < items) {
            if (it2 < items) tr_load(va, W, ldw, win_csrc(skip_ab, it2 % nblk), it2 / nblk, it2 % nblk, lane);
            tr_store(vb, kscale, K, WT, scr, it1 / nblk, it1 % nblk, lane);
        }
    }
}
__device__ __forceinline__ void rms_row_to_bf16(v4f (&v)[8], const float* g, bf16* orow, const LAS float* wabt, float* ab, int lane) {
    const v4f* gr = (const v4f*)g + lane;
    float s = 0.f;
#pragma unroll
    for (int j = 0; j < 8; ++j) s += (v[j].x * v[j].x + v[j].y * v[j].y) + (v[j].z * v[j].z + v[j].w * v[j].w);
    const float rstd = rsqrtf(wave_sum(s) * (1.f / DM) + RMS_EPS);
#pragma unroll
    for (int j = 0; j < 8; ++j) { v[j] = v[j] * rstd * gr[64 * j]; }
    v2u* o8 = (v2u*)orow + lane;
#pragma unroll
    for (int j = 0; j < 8; ++j) { v2u w; w.x = pk2(v[j].x, v[j].y); w.y = pk2(v[j].z, v[j].w); o8[64 * j] = w; }
    if (ab) {
        float a[8];
#pragma unroll
        for (int c = 0; c < 8; ++c) { float t = 0.f;
#pragma unroll
            for (int j = 0; j < 8; ++j) { const v4f w = *(const LAS v4f*)(wabt + c * DM + 256 * j + 4 * lane); t += (v[j].x * w.x + v[j].y * w.y) + (v[j].z * w.z + v[j].w * w.w); }
            a[c] = t; asm volatile("" ::: "memory"); }
        const bool b0 = lane & 1, b1 = lane & 2, b2 = lane & 4;
#pragma unroll
        for (int c = 0; c < 4; ++c) { const float send = b0 ? a[c] : a[c + 4], keep = b0 ? a[c + 4] : a[c]; a[c] = keep + __shfl_xor(send, 1); }
#pragma unroll
        for (int c = 0; c < 2; ++c) { const float send = b1 ? a[c] : a[c + 2], keep = b1 ? a[c + 2] : a[c]; a[c] = keep + __shfl_xor(send, 2); }
        { const float send = b2 ? a[0] : a[1], keep = b2 ? a[1] : a[0]; a[0] = keep + __shfl_xor(send, 4); }
        a[0] += __shfl_xor(a[0], 8); a[0] += __shfl_xor(a[0], 16); a[0] += __shfl_xor(a[0], 32);
        if (lane < 8) ab[4 * (lane & 1) + 2 * ((lane >> 1) & 1) + ((lane >> 2) & 1)] = a[0];
    }
}
__device__ __forceinline__ void rms_rows(const float* x, const float* g, bf16* o, const LAS float* wabt, float* ab, int first, int stride, int nrows, int lane) {
    v4f cur[8], nxt[8];
    if (first < nrows) {
#pragma unroll
        for (int j = 0; j < 8; ++j) cur[j] = ((const v4f*)(x + (size_t)first * DM) + lane)[64 * j];
    }
    for (int m = first; m < nrows; m += stride) {
        const bool more = (m + stride < nrows);
        if (more) {
#pragma unroll
            for (int j = 0; j < 8; ++j) nxt[j] = ((const v4f*)(x + (size_t)(m + stride) * DM) + lane)[64 * j];
        }
        rms_row_to_bf16(cur, g, o + (size_t)m * DM, wabt, ab ? ab + (size_t)m * 8 : nullptr, lane);
#pragma unroll
        for (int j = 0; j < 8; ++j) cur[j] = nxt[j];
    }
}

template <int D, bool SWA>
__device__ __forceinline__ void attn_wave(const LAS bf16* Ks, const LAS bf16* VTs, const h8 (&qf)[D / 16], bf16* Og, int ldo,
                                          int kt_lo, int kt_hi, int qi0, bool has_prev, float scale, float sink, int lane) {
    constexpr int KP = D + 8, VP = 264, NS = D / 16, ND = D / 32;
    const int lr = lane & 31, hi = lane >> 5;
    v16f o[ND];
#pragma unroll
    for (int d = 0; d < ND; ++d)
#pragma unroll
        for (int r = 0; r < 16; ++r) o[d][r] = 0.f;
    float m = SWA ? sink : -1e30f, l = SWA ? 1.f : 0.f;
    const int qi = qi0 + lr;
    for (int kt = kt_lo; kt < kt_hi; ++kt) {
        v16f p;
#pragma unroll
        for (int r = 0; r < 16; ++r) p[r] = 0.f;
#pragma unroll
        for (int s = 0; s < NS; ++s) { const h8 a = *(const LAS h8*)(Ks + (32 * kt + lr) * KP + 16 * s + 8 * hi); p = MFMA32(a, qf[s], p); }
        float tmax = -INFINITY;
#pragma unroll
        for (int r = 0; r < 16; ++r) { float v = p[r] * scale;
            if (SWA) { const int kv = 32 * kt + crow(r, hi); const bool ok = (kv > qi) && (kv <= qi + 128) && (has_prev || kv >= 128); v = ok ? v : -INFINITY; }
            p[r] = v; tmax = fmaxf(tmax, v); }
        tmax = fmaxf(tmax, __shfl_xor(tmax, 32));
        const float mnew = fmaxf(m, tmax), alpha = __expf(m - mnew);
        float ps = 0.f;
#pragma unroll
        for (int r = 0; r < 16; ++r) { p[r] = __expf(p[r] - mnew); ps += p[r]; }
        ps += __shfl_xor(ps, 32);
        l = l * alpha + ps; m = mnew;
#pragma unroll
        for (int d = 0; d < ND; ++d)
#pragma unroll
            for (int r = 0; r < 16; ++r) o[d][r] *= alpha;
        h8 pb[2];
#pragma unroll
        for (int j = 0; j < 2; ++j) { v4u w; w.x = pk2(p[8 * j + 0], p[8 * j + 1]); w.y = pk2(p[8 * j + 2], p[8 * j + 3]); w.z = pk2(p[8 * j + 4], p[8 * j + 5]); w.w = pk2(p[8 * j + 6], p[8 * j + 7]); pb[j] = __builtin_bit_cast(h8, w); }
#pragma unroll
        for (int d = 0; d < ND; ++d)
#pragma unroll
            for (int j = 0; j < 2; ++j) { const LAS bf16* vp = VTs + (32 * d + lr) * VP + 32 * kt + 16 * j + 4 * hi;
                const v2u lo = *(const LAS v2u*)vp, hh = *(const LAS v2u*)(vp + 8);
                const v4u aw = (v4u){lo.x, lo.y, hh.x, hh.y};
                o[d] = MFMA32(__builtin_bit_cast(h8, aw), pb[j], o[d]); }
    }
    const float inv = 1.0f / l;
#pragma unroll
    for (int d = 0; d < ND; ++d)
#pragma unroll
        for (int rg = 0; rg < 4; ++rg) { v2u w; w.x = pk2(o[d][4 * rg] * inv, o[d][4 * rg + 1] * inv); w.y = pk2(o[d][4 * rg + 2] * inv, o[d][4 * rg + 3] * inv);
            *(v2u*)(Og + 32 * d + 8 * rg + 4 * hi) = w; }
}
__device__ __forceinline__ void put8T(LAS bf16* VTs, int d0, int row, v4u v) {
    VTs[(d0 + 0) * 264 + row] = (bf16)(v.x & 0xffffu); VTs[(d0 + 1) * 264 + row] = (bf16)(v.x >> 16);
    VTs[(d0 + 2) * 264 + row] = (bf16)(v.y & 0xffffu); VTs[(d0 + 3) * 264 + row] = (bf16)(v.y >> 16);
    VTs[(d0 + 4) * 264 + row] = (bf16)(v.z & 0xffffu); VTs[(d0 + 5) * 264 + row] = (bf16)(v.z >> 16);
    VTs[(d0 + 6) * 264 + row] = (bf16)(v.w & 0xffffu); VTs[(d0 + 7) * 264 + row] = (bf16)(v.w >> 16);
}
__device__ __forceinline__ void swa_unit(int unit, const bf16* P, bf16* YA, const float* sinks, LAS unsigned char* lds, int tid) {
    const int nb = unit & 63, kvh = (unit >> 6) & 1, b = unit >> 7, lane = tid & 63, wave = tid >> 6, lr = lane & 31, hi = lane >> 5;
    LAS bf16* Ks = (LAS bf16*)lds; LAS bf16* VTs = (LAS bf16*)(lds + 256 * 72 * 2);
    const long rowbase = (long)b * SEQ + nb * 128 - 128;
    const int head = kvh * 8 + wave; const float sink = sinks[head];
    h8 qA[4], qB[4];
#define SWA_LOADQ(dst, qt_) do { _Pragma("unroll") for (int s_ = 0; s_ < 4; ++s_) dst[s_] = *(const h8*)(P + ((size_t)b * SEQ + nb * 128 + (qt_) * 32 + lr) * N1 + C_QA + head * 64 + 16 * s_ + 8 * hi); } while (0)
    SWA_LOADQ(qA, 0);
#pragma unroll
    for (int i = 0; i < 4; ++i) { const int id = tid + 512 * i, row = id & 255, ch = id >> 8;
        v4u kv = (v4u){0u, 0u, 0u, 0u}, vv = (v4u){0u, 0u, 0u, 0u};
        if (nb > 0 || row >= 128) { const bf16* src = P + (size_t)(rowbase + row) * N1; kv = *(const v4u*)(src + C_KA + kvh * 64 + ch * 8); vv = *(const v4u*)(src + C_VA + kvh * 64 + ch * 8); }
        *(LAS v4u*)(Ks + row * 72 + ch * 8) = kv; put8T(VTs, ch * 8, row, vv); }
    LDS_BARRIER();
#pragma unroll 1
    for (int qp = 0; qp < 2; ++qp) { const int qt = 2 * qp; const size_t tok = (size_t)b * SEQ + nb * 128 + qt * 32;
        SWA_LOADQ(qB, qt + 1);
        attn_wave<64, true>(Ks, VTs, qA, YA + (tok + lr) * 1024 + head * 64, 1024, qt, qt + 5, qt * 32, nb > 0, 0.125f, sink, lane);
        if (qp == 0) SWA_LOADQ(qA, 2);
        attn_wave<64, true>(Ks, VTs, qB, YA + (tok + 32 + lr) * 1024 + head * 64, 1024, qt + 1, qt + 6, (qt + 1) * 32, nb > 0, 0.125f, sink, lane); }
    LDS_BARRIER();
#undef SWA_LOADQ
}
__device__ __forceinline__ void xa_unit(int unit, const bf16* P, const bf16* MKV, bf16* YC, LAS unsigned char* lds, int tid) {
    const int qblk = unit & 31, h = (unit >> 5) & 3, b = unit >> 7, lane = tid & 63, wave = tid >> 6, lr = lane & 31, hi = lane >> 5;
    LAS bf16* Ks = (LAS bf16*)lds; LAS bf16* VTs = (LAS bf16*)(lds + 256 * 136 * 2);
    const size_t tok = (size_t)b * SEQ + qblk * 256 + wave * 32;
    h8 qf[8];
#pragma unroll
    for (int s = 0; s < 8; ++s) qf[s] = *(const h8*)(P + (tok + lr) * N1 + C_QC + h * 128 + 16 * s + 8 * hi);
#pragma unroll
    for (int i = 0; i < 8; ++i) { const int id = tid + 512 * i, row = id & 255, ch = id >> 8;
        const bf16* src = MKV + (size_t)(b * NMEM + row) * 1024 + h * 128 + ch * 8;
        const v4u kv = *(const v4u*)src, vv = *(const v4u*)(src + 512);
        *(LAS v4u*)(Ks + row * 136 + ch * 8) = kv; put8T(VTs, ch * 8, row, vv); }
    LDS_BARRIER();
    attn_wave<128, false>(Ks, VTs, qf, YC + (tok + lr) * 512 + h * 128, 512, 0, 8, 0, true, 0.08838834764831845f, 0.f, lane);
    LDS_BARRIER();
}

__device__ __forceinline__ void gdn_prep_unit(int uidx, const bf16* P, const float* AB, const float* conv_w, const float* a_log, const float* dt_bias,
                                              bf16* Wg, bf16* QDg, bf16* KDTg, bf16* QKg, bf16* Ug, float* GLg, LAS unsigned char* lds, int tid) {
    const int bh = uidx >> 7, n = uidx & 127, b = bh >> 2, h = bh & 3, slot = n * 8 + bh;
    LAS float* qs = (LAS float*)lds; LAS float* ks = qs + 64 * 132; LAS float* vs = ks + 64 * 132; LAS float* Lm = vs + 64 * 132; LAS float* gc = Lm + 64 * 64; LAS float* bt = gc + 64; LAS float* eg = bt + 64; LAS float* ek = eg + 64;
    const size_t tok0 = (size_t)b * SEQ + n * 64;
    if (tid < 384) {
        const int cp = tid % 192, seg = tid / 192, which = cp >> 6, cc = (cp & 63) * 2;
        const int col = C_QKVB + which * 512 + h * 128 + cc, cw = which * 512 + h * 128 + cc;
        const float wa0 = conv_w[cw], wa1 = conv_w[1536 + cw], wa2 = conv_w[3072 + cw], wa3 = conv_w[4608 + cw];
        const float wb0 = conv_w[cw + 1], wb1 = conv_w[1536 + cw + 1], wb2 = conv_w[3072 + cw + 1], wb3 = conv_w[4608 + cw + 1];
        LAS float* dst = qs + which * (64 * 132);
        const int t0 = seg * 32;
        unsigned xw[35];
#pragma unroll
        for (int i = 0; i < 35; ++i) { const int tt = t0 - 3 + i; xw[i] = (n * 64 + tt >= 0) ? *(const unsigned*)(P + (tok0 + tt) * N1 + col) : 0u; }
#pragma unroll
        for (int i = 0; i < 32; ++i) { const int t = t0 + i;
            const float ya = wa0 * bflo(xw[i]) + wa1 * bflo(xw[i + 1]) + wa2 * bflo(xw[i + 2]) + wa3 * bflo(xw[i + 3]);
            const float yb = wb0 * bfhi(xw[i]) + wb1 * bfhi(xw[i + 1]) + wb2 * bfhi(xw[i + 2]) + wb3 * bfhi(xw[i + 3]);
            typedef float f2_t __attribute__((ext_vector_type(2))); *(LAS f2_t*)(dst + t * 132 + cc) = (f2_t){ya * sigmoidf_(ya), yb * sigmoidf_(yb)}; }
    } else if (tid < 448) {
        const int t = tid - 384;
        const float a = AB[(tok0 + t) * 8 + h], bb = AB[(tok0 + t) * 8 + 4 + h];
        const float x = a + dt_bias[h], sp = x > 20.f ? x : log1pf(expf(x));
        float g = -expf(a_log[h]) * sp;
#pragma unroll
        for (int o = 1; o < 64; o <<= 1) { const float v = __shfl_up(g, o); if (t >= o) g += v; }
        gc[t] = g; bt[t] = 1.0f / (1.0f + expf(-bb)); eg[t] = __expf(g); ek[t] = __expf(__shfl(g, 63) - g);
    }
    LDS_BARRIER();
    { const int row = tid >> 2, part = tid & 3; LAS float* base = (row < 64 ? qs : ks) + (row & 63) * 132; float ss = 0.f;
#pragma unroll
      for (int i = 0; i < 32; ++i) { const float v = base[part + 4 * i]; ss += v * v; }
      ss += __shfl_xor(ss, 1); ss += __shfl_xor(ss, 2);
      const float sc = rsqrtf(ss + 1e-6f) * (row < 64 ? 0.08838834764831845f : 1.f);
#pragma unroll
      for (int i = 0; i < 32; ++i) base[part + 4 * i] *= sc; }
    LDS_BARRIER();
    { const int ib = tid >> 4, jb = tid & 15;
      float kk[2][4], qk[2][4];
#pragma unroll
      for (int y = 0; y < 2; ++y)
#pragma unroll
          for (int x = 0; x < 4; ++x) { kk[y][x] = 0.f; qk[y][x] = 0.f; }
#pragma unroll 2
      for (int d4 = 0; d4 < 32; ++d4) {
          v4f ki[2], qi[2], kj[4];
#pragma unroll
          for (int y = 0; y < 2; ++y) { ki[y] = *(const LAS v4f*)(ks + (ib + 32 * y) * 132 + 4 * d4); qi[y] = *(const LAS v4f*)(qs + (ib + 32 * y) * 132 + 4 * d4); }
#pragma unroll
          for (int x = 0; x < 4; ++x) kj[x] = *(const LAS v4f*)(ks + (jb + 16 * x) * 132 + 4 * d4);
#pragma unroll
          for (int y = 0; y < 2; ++y)
#pragma unroll
              for (int x = 0; x < 4; ++x) { kk[y][x] += (ki[y].x * kj[x].x + ki[y].y * kj[x].y) + (ki[y].z * kj[x].z + ki[y].w * kj[x].w);
                                            qk[y][x] += (qi[y].x * kj[x].x + qi[y].y * kj[x].y) + (qi[y].z * kj[x].z + qi[y].w * kj[x].w); }
      }
#pragma unroll
      for (int y = 0; y < 2; ++y)
#pragma unroll
          for (int x = 0; x < 4; ++x) { const int i = ib + 32 * y, j = jb + 16 * x;
              const float dec = (j <= i) ? __expf(gc[i] - gc[j]) : 0.f;
              Lm[j * 64 + i] = (j < i) ? bt[i] * kk[y][x] * dec : 0.f;
              QKg[(size_t)slot * 4096 + i * 64 + swap23(j)] = f2bf(qk[y][x] * dec); }
    }
    LDS_BARRIER();
    { const float gl = gc[63];
#pragma unroll 4
      for (int i = 0; i < 16; ++i) { const int e = tid + 512 * i, row = e >> 7, d = e & 127; QDg[(size_t)slot * 8192 + e] = f2bf(qs[row * 132 + swap23(d)] * eg[row]); }
#pragma unroll 4
      for (int i = 0; i < 16; ++i) { const int e = tid + 512 * i, d = e >> 6, r = swap23(e & 63); KDTg[(size_t)slot * 8192 + e] = f2bf(ks[r * 132 + d] * ek[r]); }
      if (tid == 0) GLg[slot] = eg[63]; }
    LDS_BARRIER();
    if (tid < 256) {
        const int col = tid; const bool isv = col < 128; LAS float* src = isv ? vs + col : ks + (col - 128);
#pragma unroll 1
        for (int ib = 0; ib < 8; ++ib) {
            float r[8];
#pragma unroll
            for (int e = 0; e < 8; ++e) { const int i = 8 * ib + e; float v = src[i * 132] * bt[i]; if (!isv) v *= eg[i]; r[e] = v; }
#pragma unroll 2
            for (int j = 0; j < 8 * ib; ++j) { const float sv = src[j * 132]; const v4f l0 = *(const LAS v4f*)(Lm + j * 64 + 8 * ib), l1 = *(const LAS v4f*)(Lm + j * 64 + 8 * ib + 4);
                r[0] -= l0.x * sv; r[1] -= l0.y * sv; r[2] -= l0.z * sv; r[3] -= l0.w * sv; r[4] -= l1.x * sv; r[5] -= l1.y * sv; r[6] -= l1.z * sv; r[7] -= l1.w * sv; }
#pragma unroll
            for (int e = 1; e < 8; ++e)
#pragma unroll
                for (int f = 0; f < e; ++f) r[e] -= Lm[(8 * ib + f) * 64 + 8 * ib + e] * r[f];
#pragma unroll
            for (int e = 0; e < 8; ++e) src[(8 * ib + e) * 132] = r[e];
        }
    }
    LDS_BARRIER();
#pragma unroll
    for (int i = 0; i < 2; ++i) { const int e = tid + 512 * i, dv = e & 127, cg = e >> 7; const LAS float* sp = vs + (8 * cg) * 132 + dv;
        v4u w; w.x = pk2(sp[0], sp[132]); w.y = pk2(sp[2 * 132], sp[3 * 132]); w.z = pk2(sp[4 * 132], sp[5 * 132]); w.w = pk2(sp[6 * 132], sp[7 * 132]);
        *(v4u*)(Ug + (size_t)slot * 8192 + dv * 64 + 8 * cg) = w; }
#pragma unroll
    for (int i = 0; i < 2; ++i) { const int e8 = tid + 512 * i, row = e8 >> 4, c8 = (e8 & 15) * 8, o0 = (c8 & ~15) + 4 * ((c8 >> 3) & 1);
        const v4f x0 = *(const LAS v4f*)(ks + row * 132 + o0), x1 = *(const LAS v4f*)(ks + row * 132 + o0 + 8);
        v4u w; w.x = pk2(x0.x, x0.y); w.y = pk2(x0.z, x0.w); w.z = pk2(x1.x, x1.y); w.w = pk2(x1.z, x1.w); *(v4u*)(Wg + (size_t)slot * 8192 + row * 128 + c8) = w; }
    LDS_BARRIER();
}

__device__ __forceinline__ void wg_publish_add(unsigned* word) {
    asm volatile("s_waitcnt vmcnt(0)" ::: "memory");
    __syncthreads();
    if (threadIdx.x == 0) { __builtin_amdgcn_fence(__ATOMIC_RELEASE, "agent"); asm volatile("s_waitcnt vmcnt(0)" ::: "memory"); __hip_atomic_fetch_add(word, 1u, __ATOMIC_RELAXED, __HIP_MEMORY_SCOPE_AGENT); }
}
__device__ __forceinline__ void wave_wait_ge(unsigned* word, unsigned want) {
    while (__hip_atomic_load(word, __ATOMIC_RELAXED, __HIP_MEMORY_SCOPE_AGENT) < want) __builtin_amdgcn_s_sleep(2);
    __builtin_amdgcn_fence(__ATOMIC_ACQUIRE, "agent");
    asm volatile("s_waitcnt vmcnt(0)" ::: "memory");
}
__device__ __forceinline__ h8 pack8(const v16f& x, int j) { v4u w; w.x = pk2(x[8 * j], x[8 * j + 1]); w.y = pk2(x[8 * j + 2], x[8 * j + 3]); w.z = pk2(x[8 * j + 4], x[8 * j + 5]); w.w = pk2(x[8 * j + 6], x[8 * j + 7]); return __builtin_bit_cast(h8, w); }
__device__ __forceinline__ void gdn_scan(int bh, const bf16* P, bf16* YB, const float* norm_w, const bf16* Wg, const bf16* QDg, const bf16* KDTg, const bf16* QKg, const bf16* Ug, const float* GLg, unsigned* flags,
                                         LAS unsigned char* lds, int tid) {
    constexpr int OPB = 62464;
    const int b = bh >> 2, h = bh & 3, lane = tid & 63, wave = __builtin_amdgcn_readfirstlane(tid >> 6), lr = lane & 31, hi = lane >> 5;
    LAS bf16* Ob = (LAS bf16*)(lds + 2 * OPB);
#define SLOT(nn) ((size_t)(nn) * 8 + (size_t)bh)
    LAS float* gll = (LAS float*)(lds + 2 * OPB + 64 * 136 * 2 + 512);
    if (wave == 4) { wave_wait_ge(flags + SLOT(0), 1u); wave_wait_ge(flags + SLOT(1), 1u); wave_wait_ge(flags + SLOT(2), 1u); wave_wait_ge(flags + SLOT(3), 1u); if (lane < 4) gll[lane] = GLg[SLOT(lane)]; }
    LDS_BARRIER();
    if (wave < 4) {
        const int w = wave;
        v16f sacc[4];
#pragma unroll
        for (int t = 0; t < 4; ++t)
#pragma unroll
            for (int r = 0; r < 16; ++r) sacc[t][r] = 0.f;
        v2u uA[8], uB[8];
#define SC_LOADU(dst, nn) do { const bf16* up_ = Ug + SLOT(nn) * 8192 + (size_t)(32 * w + lr) * 64 + 4 * hi; \
        _Pragma("unroll") for (int q_ = 0; q_ < 8; ++q_) dst[q_] = *(const v2u*)(up_ + 8 * q_); } while (0)
        SC_LOADU(uA, 0); SC_LOADU(uB, 1);
        LDS_BARRIER();
#define SC_CSTEP(nn, UC) do { int n_ = (nn); asm volatile("" : "+s"(n_));     \
            LAS const bf16* Wl = (LAS const bf16*)(lds + (n_ & 1) * OPB); LAS const bf16* QDl = Wl + 64 * 136; LAS const bf16* KDTl = QDl + 64 * 136; LAS const bf16* QKl = KDTl + 128 * 72; \
            const float gl = gll[n_]; \
            h8 sB[8]; \
            _Pragma("unroll") for (int t = 0; t < 4; ++t) { sB[2 * t] = pack8(sacc[t], 0); sB[2 * t + 1] = pack8(sacc[t], 1); } \
            v16f vn[2]; \
            _Pragma("unroll") for (int mt = 0; mt < 2; ++mt) { \
                _Pragma("unroll") for (int r = 0; r < 16; ++r) vn[mt][r] = 0.f; \
                _Pragma("unroll") for (int ks = 0; ks < 8; ++ks) { const h8 a = *(const LAS h8*)(Wl + (32 * mt + lr) * 136 + 16 * ks + 8 * hi); vn[mt] = MFMA32(a, sB[ks], vn[mt]); } } \
            h8 vB[4]; \
            _Pragma("unroll") for (int mt = 0; mt < 2; ++mt) { \
                _Pragma("unroll") for (int rg = 0; rg < 4; ++rg) { const v2u uu = UC[4 * mt + rg]; \
                    vn[mt][4 * rg] = bflo(uu.x) - vn[mt][4 * rg]; vn[mt][4 * rg + 1] = bfhi(uu.x) - vn[mt][4 * rg + 1]; vn[mt][4 * rg + 2] = bflo(uu.y) - vn[mt][4 * rg + 2]; vn[mt][4 * rg + 3] = bfhi(uu.y) - vn[mt][4 * rg + 3]; } \
                vB[2 * mt] = pack8(vn[mt], 0); vB[2 * mt + 1] = pack8(vn[mt], 1); } \
            if (n_ + 2 < 128) SC_LOADU(UC, n_ + 2); \
            LDS_BARRIER();                                             \
            _Pragma("unroll") for (int mt = 0; mt < 2; ++mt) { v16f o; \
                _Pragma("unroll") for (int r = 0; r < 16; ++r) o[r] = 0.f; \
                _Pragma("unroll") for (int ks = 0; ks < 8; ++ks) { const h8 a = *(const LAS h8*)(QDl + (32 * mt + lr) * 136 + 16 * ks + 8 * hi); o = MFMA32(a, sB[ks], o); } \
                _Pragma("unroll") for (int ks = 0; ks < 4; ++ks) { const h8 a = *(const LAS h8*)(QKl + (32 * mt + lr) * 72 + 16 * ks + 8 * hi); o = MFMA32(a, vB[ks], o); } \
                _Pragma("unroll") for (int r = 0; r < 16; ++r) Ob[(32 * mt + crow(r, hi)) * 136 + 32 * w + lr] = f2bf(o[r]); } \
            _Pragma("unroll") for (int t = 0; t < 4; ++t) { \
                _Pragma("unroll") for (int r = 0; r < 16; ++r) sacc[t][r] *= gl; \
                _Pragma("unroll") for (int ks = 0; ks < 4; ++ks) { const h8 a = *(const LAS h8*)(KDTl + (32 * t + lr) * 72 + 16 * ks + 8 * hi); sacc[t] = MFMA32(a, vB[ks], sacc[t]); } } \
            LDS_BARRIER();                                             \
        } while (0)
#pragma unroll 1
        for (int n = 0; n < 128; n += 2) { SC_CSTEP(n, uA); SC_CSTEP(n + 1, uB); }
        LDS_BARRIER();
#undef SC_LOADU
#undef SC_CSTEP
    } else {
        const int t2 = tid - 256, c = t2 >> 2, q = t2 & 3;
        struct OpRegs { v4u w[4], qd[4], kdt[4], qk[2]; };
        float glv = 0.f;
        OpRegs RA, RB;
#define LDG16(base, off32) (*(const v4u*)((const char*)(base) + (unsigned)(off32)))
#define SC_LOAD(R, nn) do { const size_t ub_ = SLOT(nn) * 8192; const bf16* wb_ = Wg + ub_; const bf16* qdb_ = QDg + ub_; const bf16* kb_ = KDTg + ub_; const bf16* qkb_ = QKg + SLOT(nn) * 4096; \
        _Pragma("unroll") for (int i_ = 0; i_ < 4; ++i_) { R.w[i_] = LDG16(wb_, o16 + 4096u * i_); R.qd[i_] = LDG16(qdb_, o16 + 4096u * i_); R.kdt[i_] = LDG16(kb_, o16 + 4096u * i_); } \
        _Pragma("unroll") for (int i_ = 0; i_ < 2; ++i_) R.qk[i_] = LDG16(qkb_, o16 + 4096u * i_); } while (0)
#define SC_STORE(R, buf) do { LAS bf16* Wl_ = (LAS bf16*)(lds + (buf) * OPB); LAS bf16* QDl_ = Wl_ + 64 * 136; LAS bf16* KDTl_ = QDl_ + 64 * 136; LAS bf16* QKl_ = KDTl_ + 128 * 72; \
        _Pragma("unroll") for (int i_ = 0; i_ < 4; ++i_) { const int id_ = t2 + 256 * i_; *(LAS v4u*)(Wl_ + (id_ >> 4) * 136 + (id_ & 15) * 8) = R.w[i_]; *(LAS v4u*)(QDl_ + (id_ >> 4) * 136 + (id_ & 15) * 8) = R.qd[i_]; *(LAS v4u*)(KDTl_ + (id_ >> 3) * 72 + (id_ & 7) * 8) = R.kdt[i_]; } \
        _Pragma("unroll") for (int i_ = 0; i_ < 2; ++i_) { const int id_ = t2 + 256 * i_; *(LAS v4u*)(QKl_ + (id_ >> 3) * 72 + (id_ & 7) * 8) = R.qk[i_]; } } while (0)
        const unsigned o16 = (unsigned)t2 * 16u, yoff = ((unsigned)c * 512u + 32u * q) * 2u;
        LAS float* nwl = (LAS float*)(lds + 2 * OPB + 64 * 136 * 2);
        if (t2 < 128) nwl[t2] = norm_w[t2];
        SC_LOAD(RA, 0); SC_STORE(RA, 0); asm volatile("" ::: "memory"); SC_LOAD(RA, 1); SC_LOAD(RB, 2);
        LDS_BARRIER();
#define SC_LITER(nn, R) do { int n_ = (nn); asm volatile("" : "+s"(n_)); \
            unsigned fl_ = 1u; \
            if (wave == 4) { if (n_ >= 1 && n_ + 3 < 128 && lane == 0) gll[n_ + 3] = glv; \
                             if (n_ + 4 < 128) fl_ = __hip_atomic_load(flags + SLOT(n_ + 4), __ATOMIC_RELAXED, __HIP_MEMORY_SCOPE_AGENT); }     \
            v4u ov[4]; \
            bf16* yb_ = YB + ((size_t)b * SEQ + (size_t)(n_ - 1) * 64) * 512 + h * 128; \
            if (n_ >= 1) { _Pragma("unroll") for (int i = 0; i < 4; ++i) ov[i] = *(const LAS v4u*)(Ob + c * 136 + 32 * q + 8 * i); } \
            LDS_BARRIER();                                             \
            if (wave == 4 && n_ + 4 < 128) { while (fl_ == 0u) { __builtin_amdgcn_s_sleep(1); fl_ = __hip_atomic_load(flags + SLOT(n_ + 4), __ATOMIC_RELAXED, __HIP_MEMORY_SCOPE_AGENT); } \
                __builtin_amdgcn_fence(__ATOMIC_ACQUIRE, "agent"); glv = GLg[SLOT(n_ + 4)]; }     \
            if (n_ + 1 < 128) { SC_STORE(R, (n_ + 1) & 1); asm volatile("" ::: "memory"); if (n_ + 3 < 128) SC_LOAD(R, n_ + 3); } \
            if (n_ >= 1) { \
                float ss = 0.f; \
                _Pragma("unroll") for (int i = 0; i < 4; ++i) { const float a0 = bflo(ov[i].x), a1 = bfhi(ov[i].x), a2 = bflo(ov[i].y), a3 = bfhi(ov[i].y), a4 = bflo(ov[i].z), a5 = bfhi(ov[i].z), a6 = bflo(ov[i].w), a7 = bfhi(ov[i].w); \
                    ss += (a0 * a0 + a1 * a1) + (a2 * a2 + a3 * a3) + (a4 * a4 + a5 * a5) + (a6 * a6 + a7 * a7); } \
                ss += __shfl_xor(ss, 1); ss += __shfl_xor(ss, 2); \
                const float rstd = rsqrtf(ss * (1.f / 128.f) + RMS_EPS); \
                _Pragma("unroll") for (int i = 0; i < 4; ++i) { const v4f n0 = *(const LAS v4f*)(nwl + 32 * q + 8 * i), n1 = *(const LAS v4f*)(nwl + 32 * q + 8 * i + 4); \
                    v4u y; \
                    y.x = pk2(bflo(ov[i].x) * rstd * n0.x, bfhi(ov[i].x) * rstd * n0.y); y.y = pk2(bflo(ov[i].y) * rstd * n0.z, bfhi(ov[i].y) * rstd * n0.w); \
                    y.z = pk2(bflo(ov[i].z) * rstd * n1.x, bfhi(ov[i].z) * rstd * n1.y); y.w = pk2(bflo(ov[i].w) * rstd * n1.z, bfhi(ov[i].w) * rstd * n1.w); \
                    *(v4u*)((char*)yb_ + (yoff + 16u * i)) = y; asm volatile("" ::: "memory"); } \
            } \
            if (n_ < 128) LDS_BARRIER();                               \
        } while (0)
#pragma unroll 1
        for (int n = 0; n < 128; n += 2) { SC_LITER(n, RA); SC_LITER(n + 1, RB); }
        SC_LITER(128, RA);
#undef SC_LOAD
#undef SC_STORE
#undef SC_LITER
#undef SLOT
    }
}

#define XB_TMO      128
#define XB_XCNT(j)  (256  + 64 * (j))
#define XB_XSUB(j)  (1280 + 64 * (j))
#define XB_XGEN(j)  (2304 + 64 * (j))
#define XB_TOP      3328
#define XB_TOPGEN   3392
#define XCD_BAR_WORDS 3456
#define XB_SPIN_CAP (1u << 18)

__device__ __forceinline__ unsigned xb_ld(unsigned* p)              { return __hip_atomic_load(p, __ATOMIC_RELAXED, __HIP_MEMORY_SCOPE_AGENT); }
__device__ __forceinline__ unsigned xb_add(unsigned* p, unsigned v) { return __hip_atomic_fetch_add(p, v, __ATOMIC_RELAXED, __HIP_MEMORY_SCOPE_AGENT); }
__device__ __forceinline__ unsigned xb_xcc_id() { return (unsigned)__builtin_amdgcn_s_getreg((3 << 11) | 20) & 0xFu; }
#define XB_SPIN(cond, bar) do { unsigned _sp = 0; while (cond) { __builtin_amdgcn_s_sleep(1); \
    if ((++_sp & 255u) == 0u) { if (xb_ld(&(bar)[XB_TMO])) break; if (_sp > XB_SPIN_CAP) { atomicAdd(&(bar)[XB_TMO], 1u); break; } } } } while (0)

struct XcdBarrier {
    unsigned* bar; unsigned x;
    volatile LAS unsigned* st;
};

__device__ __forceinline__ XcdBarrier xcd_barrier_post(unsigned* bar, volatile LAS unsigned* st) {
    XcdBarrier b; b.bar = bar; b.x = xb_xcc_id(); b.st = st;
    if (threadIdx.x == 0) (void)xb_add(&bar[XB_XCNT(b.x)], 1u);
    return b;
}
__device__ __forceinline__ void xcd_barrier_complete(unsigned* bar, unsigned x, unsigned& nloc, unsigned& nx) {
    const unsigned G = gridDim.x * gridDim.y * gridDim.z;
    unsigned sum, cnt, mine, sp = 0u;
    for (;;) {
        sum = 0u; cnt = 0u; mine = 0u;
#pragma unroll
        for (unsigned j = 0; j < 16; ++j) { const unsigned c = xb_ld(&bar[XB_XCNT(j)]); sum += c; cnt += (c > 0u) ? 1u : 0u; mine = (j == x) ? c : mine; }
        if (sum == G) break;
        __builtin_amdgcn_s_sleep(1);
        if ((++sp & 255u) == 0u) { if (xb_ld(&bar[XB_TMO])) break; if (sp > XB_SPIN_CAP) { atomicAdd(&bar[XB_TMO], 1u); break; } }
    }
    nloc = mine > 0u ? mine : 1u; nx = cnt > 0u ? cnt : 1u;
}

__device__ __forceinline__ void xcd_barrier(const XcdBarrier& b) {
    asm volatile("s_waitcnt vmcnt(0)" ::: "memory");
    __syncthreads();
    if (threadIdx.x == 0) {
        unsigned* bar = b.bar;
        __builtin_amdgcn_s_waitcnt(0);
        unsigned nloc = b.st[0], nx = b.st[1];
        if (nloc == 0u) { xcd_barrier_complete(bar, b.x, nloc, nx); b.st[0] = nloc; b.st[1] = nx; }
        const unsigned old = xb_add(&bar[XB_XSUB(b.x)], 1u);
        const unsigned gen = old / nloc;
        if (old + 1u == (gen + 1u) * nloc) {
            __builtin_amdgcn_fence(__ATOMIC_RELEASE, "agent");
            asm volatile("s_waitcnt vmcnt(0)" ::: "memory");
            const unsigned og = xb_add(&bar[XB_TOP], 1u);
            const unsigned tg = og / nx;
            if (og + 1u == (tg + 1u) * nx) xb_add(&bar[XB_TOPGEN], 1u);
            else XB_SPIN(xb_ld(&bar[XB_TOPGEN]) == tg, bar);
            __builtin_amdgcn_fence(__ATOMIC_ACQUIRE, "agent");
            xb_add(&bar[XB_XGEN(b.x)], 1u);
            asm volatile("s_waitcnt vmcnt(0)" ::: "memory");
        } else {
            XB_SPIN(xb_ld(&bar[XB_XGEN(b.x)]) == gen, bar);
            __builtin_amdgcn_fence(__ATOMIC_ACQUIRE, "agent");
            asm volatile("s_waitcnt vmcnt(0)" ::: "memory");
        }
    }
    __syncthreads();
}
__device__ __forceinline__ void group_barrier(unsigned* cnt, unsigned nwg) {
    asm volatile("s_waitcnt vmcnt(0)" ::: "memory");
    __syncthreads();
    if (threadIdx.x == 0) {
        __builtin_amdgcn_fence(__ATOMIC_RELEASE, "agent");
        asm volatile("s_waitcnt vmcnt(0)" ::: "memory");
        __hip_atomic_fetch_add(cnt, 1u, __ATOMIC_RELAXED, __HIP_MEMORY_SCOPE_AGENT);
        while (__hip_atomic_load(cnt, __ATOMIC_RELAXED, __HIP_MEMORY_SCOPE_AGENT) < nwg) __builtin_amdgcn_s_sleep(2);
        __builtin_amdgcn_fence(__ATOMIC_ACQUIRE, "agent");
        asm volatile("s_waitcnt vmcnt(0)" ::: "memory");
    }
    __syncthreads();
}
struct Args { const float* in[19]; float* out; unsigned char* ws; };
__device__ __forceinline__ int tid_() { int t = threadIdx.x; asm volatile("" : "+v"(t)); return t; }
__global__ void __launch_bounds__(512, 2) fwd_megakernel(Args args) {
    extern __shared__ __attribute__((aligned(16))) unsigned char lds_raw[];
    cooperative_groups::grid_group grid = cooperative_groups::this_grid();
    LAS unsigned char* lds = (LAS unsigned char*)lds_raw;
    volatile LAS unsigned* xb_st = (volatile LAS unsigned*)(lds + LDS_BYTES - 16);
    if (threadIdx.x == 0) { xb_st[0] = 0u; xb_st[1] = 0u; }
    __syncthreads();
    const int G = gridDim.x, blk = blockIdx.x;
#define PHASE_IDS() const int tid = tid_(), lane = tid & 63, wave = __builtin_amdgcn_readfirstlane(tid >> 6), gw = blk * 8 + wave, NGW = G * 8; (void)lane; (void)gw; (void)NGW
    unsigned char* ws = args.ws;
    const float* x = args.in[0]; const float* mem = args.in[1]; const float* g_mix = args.in[2]; const float* w_in = args.in[3]; const float* sinks = args.in[4];
    const float* conv_w = args.in[5]; const float* a_log = args.in[6]; const float* dt_bias = args.in[7]; const float* gdn_norm_w = args.in[8]; const float* g_mem = args.in[9];
    const float* w_mem_kv = args.in[10]; const float* w_swa_up = args.in[11]; const float* w_gdn_up = args.in[12]; const float* w_xa_up = args.in[13]; const float* w_out = args.in[14];
    const float* g_mlp = args.in[15]; const float* w_mlp_in = args.in[16]; const float* w_mlp_out = args.in[17]; const float* g_final = args.in[18];
    float* out = args.out;
    float* ssq1 = (float*)(ws + WS_SSQ1); float* ssq2 = (float*)(ws + WS_SSQ2); float* AB = (float*)(ws + WS_AB); float* GL = (float*)(ws + WS_GL);
    bf16* MKV = (bf16*)(ws + WS_MKV); bf16* MEMN = (bf16*)(ws + WS_MEMN);
    bf16* WINT = (bf16*)(ws + WS_WINT); bf16* WMKVT = (bf16*)(ws + WS_WMKVT); bf16* WSWAT = (bf16*)(ws + WS_WSWAT); bf16* WGDNT = (bf16*)(ws + WS_WGDNT); bf16* WXAT = (bf16*)(ws + WS_WXAT); bf16* WOUTT = (bf16*)(ws + WS_WOUTT);
    bf16* P = (bf16*)(ws + WS_P); bf16* MERGED = (bf16*)(ws + WS_MERGED); bf16* HB = (bf16*)(ws + WS_HB);
    bf16* GW = (bf16*)(ws + WS_GW); bf16* GQD = (bf16*)(ws + WS_GQD); bf16* GKDT = (bf16*)(ws + WS_GKDT); bf16* GQK = (bf16*)(ws + WS_GQK); float* GU = (float*)(ws + WS_GU);
    bf16* W1T = (bf16*)(ws + WS_W1T); bf16* HMID = (bf16*)(ws + WS_HMID); bf16* W2T = (bf16*)out;
    bf16* XN = (bf16*)out; bf16* YA = (bf16*)((unsigned char*)out + 64 * MiB); bf16* YB = (bf16*)((unsigned char*)out + 96 * MiB); bf16* YC = (bf16*)((unsigned char*)out + 112 * MiB);

    for (int rep_ = 0; rep_ < REP_P0; ++rep_) {
        PHASE_IDS();
        LDS_BARRIER();
        for (int i = blk * 512 + tid; i < 2 * MTOK; i += G * 512) ssq1[i] = 0.f;
        if (blk == 0) for (int i = tid; i < 4096 + 1024; i += 512) ((unsigned*)(ws + WS_CNT))[i] = 0u;
        if (blk == 1) for (int i = tid; i < XCD_BAR_WORDS; i += 512) ((unsigned*)(ws + WS_CNT + 65536))[i] = 0u;
        LAS float* wabt = (LAS float*)(lds + 8 * 8448);
#pragma unroll
        for (int it = 0; it < 32; ++it) { const int idx = tid + 512 * it, k = idx >> 3, j = idx & 7; wabt[j * DM + k] = w_in[(size_t)k * INW + O_AB + j]; }
        LAS float* scr = (LAS float*)(lds + wave * 8448);
        int off = 0;
        transpose_matrix(w_in, INW, DM, N1, true, nullptr, WINT, scr, gw, NGW, off, lane);
        transpose_matrix(w_mem_kv, 1024, DM, 1024, false, nullptr, WMKVT, scr, gw, NGW, off, lane);
        LDS_BARRIER();
        rms_rows(x, g_mix, XN, wabt, AB, gw, NGW, MTOK, lane);
        rms_rows(mem, g_mem, MEMN, nullptr, nullptr, gw, NGW, BATCH * NMEM, lane);
    }
    grid.sync();
    const XcdBarrier xb = xcd_barrier_post((unsigned*)(ws + WS_CNT + 65536), xb_st);
    { pg8::Gemm g{XN, WINT, MTOK, NA, DM}; pg8::StaticOrder S; S.init(MTOK, NA, G, blk); pg8::EpiStore E{P, N1};
      pg8::gemm_phase<pg8::EpiStore, pg8::StaticOrder, PG8_ALIGN, PG8_SP2>(lds, g, S, E); }
    xcd_barrier(xb);
    unsigned* const flags = (unsigned*)(ws + WS_CNT) + 4096;
    unsigned* const mkv_cnt = (unsigned*)(ws + WS_CNT) + 64 * 8;
    if (blk < 8) { PHASE_IDS(); gdn_scan(blk, P, YB, gdn_norm_w, GW, GQD, GKDT, GQK, (bf16*)GU, GL, flags, lds, tid); }
    else {
        if (blk >= G - 8) {
            pg8::Gemm g{MEMN, WMKVT, BATCH * NMEM, 1024, DM}; pg8::StaticOrder S; S.init(BATCH * NMEM, 1024, G, G - 1 - blk); pg8::EpiStore E{MKV, 1024};
            pg8::gemm_phase<pg8::EpiStore, pg8::StaticOrder, PG8_ALIGN, PG8_SP2>(lds, g, S, E);
            wg_publish_add(mkv_cnt);
        }
        const int uplim = (blk >= G - 8) ? 1024 - 32 - (G - 8) : 1024 - 32;
        for (int up = blk - 8; up < uplim; up += G - 8) { PHASE_IDS(); const int uidx = (up & 7) * 128 + (up >> 3);
            gdn_prep_unit(uidx, P, AB, conv_w, a_log, dt_bias, GW, GQD, GKDT, GQK, (bf16*)GU, GL, lds, tid);
            wg_publish_add(flags + up); }
        { pg8::Gemm g{XN, WINT + (size_t)NA * DM, MTOK, N1 - NA, DM}; pg8::StaticOrder S; S.init(MTOK, N1 - NA, G - 8, blk - 8); pg8::EpiStore E{P + NA, N1};
          pg8::gemm_phase<pg8::EpiStore, pg8::StaticOrder, PG8_ALIGN, PG8_SP2>(lds, g, S, E); }
        group_barrier((unsigned*)(ws + WS_CNT) + 64 * 9, (unsigned)(G - 8));
        { PHASE_IDS();
          if (wave == 0) wave_wait_ge(mkv_cnt, 8u);
          __syncthreads();
          for (int it = (G - 1) - blk; it < 512; it += G - 8) { if (it < 256) swa_unit(it, P, YA, sinks, lds, tid); else xa_unit(it - 256, P, MKV, YC, lds, tid); }
        }
        if (blk - 8 >= 32 && blk - 8 < 72) { PHASE_IDS(); const int cw_ = blk - 8, up = (cw_ < 64) ? 1024 - 32 + (cw_ - 32) : 1024 - 32 - (G - 8) + (G - 16) + (cw_ - 64), uidx = (up & 7) * 128 + (up >> 3);
            gdn_prep_unit(uidx, P, AB, conv_w, a_log, dt_bias, GW, GQD, GKDT, GQK, (bf16*)GU, GL, lds, tid);
            wg_publish_add(flags + up); }
        { PHASE_IDS();
          LAS float* scr = (LAS float*)(lds + wave * 8448); int off = 0;
          const int cw_ = blk - 8;
          if (cw_ < 32 || cw_ >= 72) { const int gw2 = (cw_ < 32 ? cw_ : cw_ - 40) * 8 + wave, ngw2 = (G - 48) * 8;
              transpose_matrix(w_mlp_in, DFF, DM, DFF, false, g_mlp, W1T, scr, gw2, ngw2, off, lane);
              transpose_matrix(w_mlp_out, DM, DFF, DM, false, nullptr, W2T, scr, gw2, ngw2, off, lane);
              transpose_matrix(w_swa_up, DM, 1024, DM, false, nullptr, WSWAT, scr, gw2, ngw2, off, lane);
              transpose_matrix(w_gdn_up, DM, 512, DM, false, nullptr, WGDNT, scr, gw2, ngw2, off, lane);
              transpose_matrix(w_xa_up, DM, 512, DM, false, nullptr, WXAT, scr, gw2, ngw2, off, lane);
              transpose_matrix(w_out, DM, DM, DM, false, nullptr, WOUTT, scr, gw2, ngw2, off, lane); }
          LDS_BARRIER(); }
    }
    xcd_barrier(xb);
    { PHASE_IDS();
      for (int e = blk * 512 + tid; e < MTOK * 64; e += G * 512) { const int tok = e >> 6, c8 = (e & 63) * 8;
          v4u y = *(const v4u*)(YB + (size_t)tok * 512 + c8); const v4u z = *(const v4u*)(P + (size_t)tok * N1 + C_ZB + c8);
          const float z0 = bflo(z.x), z1 = bfhi(z.x), z2 = bflo(z.y), z3 = bfhi(z.y), z4 = bflo(z.z), z5 = bfhi(z.z), z6 = bflo(z.w), z7 = bfhi(z.w);
          y.x = pk2(bflo(y.x) * (z0 * sigmoidf_(z0)), bfhi(y.x) * (z1 * sigmoidf_(z1))); y.y = pk2(bflo(y.y) * (z2 * sigmoidf_(z2)), bfhi(y.y) * (z3 * sigmoidf_(z3)));
          y.z = pk2(bflo(y.z) * (z4 * sigmoidf_(z4)), bfhi(y.z) * (z5 * sigmoidf_(z5))); y.w = pk2(bflo(y.w) * (z6 * sigmoidf_(z6)), bfhi(y.w) * (z7 * sigmoidf_(z7)));
          *(v4u*)(YB + (size_t)tok * 512 + c8) = y; }
    }
    { pg8::StaticOrder S; S.init(MTOK, DM, G, blk);
      { pg8::Gemm g{YA, WSWAT, MTOK, DM, 1024}; pg8::EpiGate E{P + C_GATE, N1, MERGED, DM, 1}; pg8::gemm_phase<pg8::EpiGate, pg8::StaticOrder, PG8_ALIGN, PG8_SP2>(lds, g, S, E); }
      { pg8::Gemm g{YC, WXAT, MTOK, DM, 512}; pg8::EpiGate E{P + C_GATE + 2 * DM, N1, MERGED, DM, 0}; pg8::gemm_phase<pg8::EpiGate, pg8::StaticOrder, PG8_ALIGN, PG8_SP2>(lds, g, S, E); }
      xcd_barrier(xb);
      { pg8::Gemm g{YB, WGDNT, MTOK, DM, 512}; pg8::EpiGate E{P + C_GATE + DM, N1, MERGED, DM, 0}; pg8::gemm_phase<pg8::EpiGate, pg8::StaticOrder, PG8_ALIGN, PG8_SP2>(lds, g, S, E); } }
    xcd_barrier(xb);
    {
        PHASE_IDS();
        LAS float* scr = (LAS float*)(lds + wave * 8448);
        int off = 0;
        LDS_BARRIER();
        pg8::Gemm g{MERGED, WOUTT, MTOK, DM, DM}; pg8::StaticOrder S; S.init(MTOK, DM, G, blk); pg8::EpiResid E{x, nullptr, nullptr, HB, ssq1, DM};
        pg8::gemm_phase<pg8::EpiResid, pg8::StaticOrder, PG8_ALIGN, PG8_SP2>(lds, g, S, E);
    }
    xcd_barrier(xb);
    { pg8::Gemm g{HB, W1T, MTOK, DFF, DM}; pg8::StaticOrder S; S.init(MTOK, DFF, G, blk); pg8::EpiRelu2 E{HMID, DFF, ssq1, 1.f / DM, RMS_EPS};
      pg8::gemm_phase<pg8::EpiRelu2, pg8::StaticOrder, PG8_ALIGN, PG8_SP2>(lds, g, S, E); }
    xcd_barrier(xb);
    { pg8::Gemm g{HMID, W2T, MTOK, DM, DFF}; pg8::StaticOrder S; S.init(MTOK, DM, G, blk); pg8::EpiResid E{nullptr, HB, nullptr, HB, ssq2, DM};
      pg8::gemm_phase<pg8::EpiResid, pg8::StaticOrder, PG8_ALIGN, PG8_SP2>(lds, g, S, E); }
    xcd_barrier(xb);
    { PHASE_IDS();
    for (int m = gw; m < MTOK; m += NGW) {
        const float rstd = rsqrtf(ssq2[m] * (1.f / DM) + RMS_EPS);
        const v4u* h4 = (const v4u*)(HB + (size_t)m * DM) + lane; v4f* o4 = (v4f*)(out + (size_t)m * DM) + 2 * lane; const v4f* g4 = (const v4f*)g_final + 2 * lane;
#pragma unroll
        for (int j = 0; j < 4; ++j) { const v4u w = h4[64 * j]; const v4f ga = g4[128 * j], gb = g4[128 * j + 1];
            o4[128 * j] = (v4f){bflo(w.x), bfhi(w.x), bflo(w.y), bfhi(w.y)} * rstd * ga; o4[128 * j + 1] = (v4f){bflo(w.z), bfhi(w.z), bflo(w.w), bfhi(w.w)} * rstd * gb; }
    } }
}

extern "C" void kernel_launch(void* const* d_in, const int* in_sizes, int n_in, void* d_out, int out_size, void* d_ws, size_t ws_size, hipStream_t stream) {
    static int grid = 0;
    if (grid == 0) {
        if (n_in != 19 || in_sizes[0] != MTOK * DM || out_size != MTOK * DM || ws_size < WS_END) {
            fprintf(stderr, "kernel_launch: unexpected problem (n_in %d, in0 %d, out %d, ws %zu; need ws >= %zu); nothing launched\n", n_in, n_in > 0 ? in_sizes[0] : -1, out_size, ws_size, (size_t)WS_END); grid = -1; return; }
        int dev = 0, cus = 0, per_cu = 0;
        if (hipGetDevice(&dev) != hipSuccess || hipDeviceGetAttribute(&cus, hipDeviceAttributeMultiprocessorCount, dev) != hipSuccess) { fprintf(stderr, "kernel_launch: device query failed\n"); grid = -1; return; }
        if (hipFuncSetAttribute((const void*)fwd_megakernel, hipFuncAttributeMaxDynamicSharedMemorySize, LDS_BYTES) != hipSuccess) { fprintf(stderr, "kernel_launch: hipFuncSetAttribute failed\n"); grid = -1; return; }
        if (hipOccupancyMaxActiveBlocksPerMultiprocessor(&per_cu, (const void*)fwd_megakernel, 512, LDS_BYTES) != hipSuccess || per_cu < 1) { fprintf(stderr, "kernel_launch: occupancy query says %d blocks per CU\n", per_cu); per_cu = 1; }
        (void)hipGetLastError();
        grid = cus;
    }
    if (grid < 0) return;
    Args a{};
    for (int i = 0; i < 19; ++i) a.in[i] = (const float*)d_in[i];
    a.out = (float*)d_out; a.ws = (unsigned char*)d_ws;
    void* kargs[] = {&a};
    const hipError_t e = hipLaunchCooperativeKernel((const void*)fwd_megakernel, dim3(grid), dim3(512), kargs, LDS_BYTES, stream);
    if (e != hipSuccess) fprintf(stderr, "kernel_launch: cooperative launch failed: %s (grid %d)\n", hipGetErrorString(e), grid);
}
```

```cpp
#include <hip/hip_runtime.h>
#include <hip/hip_cooperative_groups.h>
#include <cstdio>
#include <cstdint>
#include <cmath>
namespace pg8 {
#define PG8_LAS __attribute__((address_space(3)))
typedef unsigned short bf16_t;
typedef short bf16x8 __attribute__((ext_vector_type(8)));
typedef float f32x4 __attribute__((ext_vector_type(4)));
typedef unsigned u32x4 __attribute__((ext_vector_type(4)));
constexpr int BM = 256, BK = 64, HALF = 128, HTB = HALF * BK * 2  , STAGE_BYTES = 8 * HTB, NXCD = 8, WGM = 8;

__host__ __device__ __forceinline__ int lds_byte(int r, int c) { const int st = (r >> 4) * 2 + (c >> 5), rr = r & 15, cc = c & 31, ob = rr * 64 + cc * 2; return st * 1024 + (ob ^ (((ob >> 9) & 1) << 5)); }
__host__ __device__ __forceinline__ void stage_rc(int b, int& R, int& C) { const int st = b / 1024, sb = b % 1024, swz = sb ^ (((sb >> 9) & 1) << 5); R = (st >> 1) * 16 + swz / 64; C = (st & 1) * 32 + (swz % 64) / 2; }
__host__ __device__ __forceinline__ int perm32(int rho) { const int n = rho >> 4, i = rho & 15; return 8 * (i >> 2) + 4 * n + (i & 3); }

struct Unit { int pm, pn; };
struct Gemm { const bf16_t* A; const bf16_t* Bt; int M, N, K; };

struct StaticOrder {
    int nM, nN, nwg, G, c;
    __host__ __device__ void init(int M, int N, int G_, int c_) { nM = M / BM; nN = N / BM; nwg = nM * nN; G = G_; c = c_; }
    __host__ __device__ bool next(int i, Unit& u) const {
        const long L = (long)i * G + c; if (L >= nwg) return false;
        int wgid = (int)L; { const int q = nwg / NXCD, r = nwg % NXCD, xcd = wgid % NXCD, off = wgid / NXCD; wgid = (xcd < r ? xcd * (q + 1) : r * (q + 1) + (xcd - r) * q) + off; }
        const int nig = WGM * nN, gid = wgid / nig, fm = gid * WGM, gsz = (nM - fm) < WGM ? (nM - fm) : WGM;
        u.pm = fm + ((wgid % nig) % gsz); u.pn = (wgid % nig) / gsz; return true;
    }
    __device__ __forceinline__ void a_ready(const Unit&) const {}
    __device__ __forceinline__ void done(const Unit&) const {}
};

typedef float f32x2c_t __attribute__((ext_vector_type(2))); typedef __bf16 bf16x2c_t __attribute__((ext_vector_type(2)));
__device__ __forceinline__ unsigned cvt_pk_bf16(float lo, float hi) { const f32x2c_t v = {lo, hi}; const bf16x2c_t b = __builtin_convertvector(v, bf16x2c_t); return __builtin_bit_cast(unsigned, b); }
typedef float f32x2 __attribute__((ext_vector_type(2)));
typedef unsigned u32x2 __attribute__((ext_vector_type(2)));
__device__ __forceinline__ float bf_lo(unsigned w) { return __uint_as_float(w << 16); }
__device__ __forceinline__ float bf_hi(unsigned w) { return __uint_as_float(w & 0xffff0000u); }
struct EpiStore {
    static constexpr bool PERM = true, AFTER_DRAIN = false;
    bf16_t* O; int ldc;
    __device__ __forceinline__ void operator()(const f32x4 (&acc)[2][2][4][2], const Unit& u, int wr, int wc, int fr, int fq) const {
        const int row0 = u.pm * BM + wr * 64 + fr, col0 = u.pn * BM + wc * 32 + 8 * fq;
#pragma unroll
        for (int ai = 0; ai < 2; ++ai)
#pragma unroll
            for (int m = 0; m < 4; ++m) { bf16_t* rowp = O + (size_t)(row0 + ai * HALF + m * 16) * ldc + col0;
#pragma unroll
                for (int bj = 0; bj < 2; ++bj) { const f32x4 v0 = acc[ai][bj][m][0], v1 = acc[ai][bj][m][1];
                    u32x4 w; w.x = cvt_pk_bf16(v0[0], v0[1]); w.y = cvt_pk_bf16(v0[2], v0[3]); w.z = cvt_pk_bf16(v1[0], v1[1]); w.w = cvt_pk_bf16(v1[2], v1[3]);
                    *(u32x4*)(rowp + bj * HALF) = w; } }
    }
};
struct EpiGate {
    static constexpr bool PERM = true, AFTER_DRAIN = false;
    const bf16_t* gate; int ldg; bf16_t* mg; int ldm; int first;
    __device__ __forceinline__ void operator()(const f32x4 (&acc)[2][2][4][2], const Unit& u, int wr, int wc, int fr, int fq) const {
        const int row0 = u.pm * BM + wr * 64 + fr, col0 = u.pn * BM + wc * 32 + 8 * fq;
#pragma unroll
        for (int ai = 0; ai < 2; ++ai)
#pragma unroll
            for (int m = 0; m < 4; ++m) { const size_t row = (size_t)(row0 + ai * HALF + m * 16);
#pragma unroll
                for (int bj = 0; bj < 2; ++bj) { const int col = col0 + bj * HALF;
                    const u32x4 gw = *(const u32x4*)(gate + row * ldg + col);
                    const f32x4 v0 = acc[ai][bj][m][0], v1 = acc[ai][bj][m][1];
                    float g[8] = {bf_lo(gw.x), bf_hi(gw.x), bf_lo(gw.y), bf_hi(gw.y), bf_lo(gw.z), bf_hi(gw.z), bf_lo(gw.w), bf_hi(gw.w)};
                    float r[8] = {v0[0], v0[1], v0[2], v0[3], v1[0], v1[1], v1[2], v1[3]};
#pragma unroll
                    for (int e = 0; e < 8; ++e) r[e] *= __builtin_amdgcn_rcpf(1.0f + __expf(-g[e]));
                    bf16_t* mp = mg + row * ldm + col;
                    if (!first) { const u32x4 ow = *(const u32x4*)mp;
                        r[0] += bf_lo(ow.x); r[1] += bf_hi(ow.x); r[2] += bf_lo(ow.y); r[3] += bf_hi(ow.y); r[4] += bf_lo(ow.z); r[5] += bf_hi(ow.z); r[6] += bf_lo(ow.w); r[7] += bf_hi(ow.w); }
                    u32x4 w; w.x = cvt_pk_bf16(r[0], r[1]); w.y = cvt_pk_bf16(r[2], r[3]); w.z = cvt_pk_bf16(r[4], r[5]); w.w = cvt_pk_bf16(r[6], r[7]);
                    *(u32x4*)mp = w; } }
    }
};
struct EpiResid {
    static constexpr bool PERM = false, AFTER_DRAIN = false;
    const float* base; const bf16_t* baseb; float* out; bf16_t* ob; float* ssq; int ldc;
    __device__ __forceinline__ void operator()(const f32x4 (&acc)[2][2][4][2], const Unit& u, int wr, int wc, int fr, int fq) const {
        const int col0 = u.pn * BM + wc * 32 + 4 * fq;
#pragma unroll
        for (int ai = 0; ai < 2; ++ai)
#pragma unroll
            for (int m = 0; m < 4; ++m) { const int row = u.pm * BM + ai * HALF + wr * 64 + m * 16 + fr; const size_t off = (size_t)row * ldc + col0; float s = 0.f;
#pragma unroll
                for (int bj = 0; bj < 2; ++bj)
#pragma unroll
                    for (int n = 0; n < 2; ++n) { const size_t o2 = off + bj * HALF + n * 16;
                        f32x4 b;
                        if (baseb) { const u32x2 w = *(const u32x2*)(baseb + o2); b = (f32x4){bf_lo(w.x), bf_hi(w.x), bf_lo(w.y), bf_hi(w.y)}; } else b = *(const f32x4*)(base + o2);
                        const f32x4 o = b + acc[ai][bj][m][n];
                        if (out) *(f32x4*)(out + o2) = o;
                        s += (o[0] * o[0] + o[1] * o[1]) + (o[2] * o[2] + o[3] * o[3]);
                        if (ob) { u32x2 w; w.x = cvt_pk_bf16(o[0], o[1]); w.y = cvt_pk_bf16(o[2], o[3]); *(u32x2*)(ob + o2) = w; } }
                s += __shfl_xor(s, 16); s += __shfl_xor(s, 32);
                if (fq == 0) unsafeAtomicAdd(ssq + row, s); }
    }
};
struct EpiRelu2 {
    static constexpr bool PERM = true, AFTER_DRAIN = false;
    bf16_t* O; int ldc; const float* ssq; float inv_n, eps;
    __device__ __forceinline__ void operator()(const f32x4 (&acc)[2][2][4][2], const Unit& u, int wr, int wc, int fr, int fq) const {
        const int row0 = u.pm * BM + wr * 64 + fr, col0 = u.pn * BM + wc * 32 + 8 * fq;
#pragma unroll
        for (int ai = 0; ai < 2; ++ai)
#pragma unroll
            for (int m = 0; m < 4; ++m) { const int row = row0 + ai * HALF + m * 16; const float rs = rsqrtf(ssq[row] * inv_n + eps); bf16_t* rowp = O + (size_t)row * ldc + col0;
#pragma unroll
                for (int bj = 0; bj < 2; ++bj) { f32x4 v0 = acc[ai][bj][m][0] * rs, v1 = acc[ai][bj][m][1] * rs;
#pragma unroll
                    for (int e = 0; e < 4; ++e) { v0[e] = fmaxf(v0[e], 0.f); v0[e] *= v0[e]; v1[e] = fmaxf(v1[e], 0.f); v1[e] *= v1[e]; }
                    u32x4 w; w.x = cvt_pk_bf16(v0[0], v0[1]); w.y = cvt_pk_bf16(v0[2], v0[3]); w.z = cvt_pk_bf16(v1[0], v1[1]); w.w = cvt_pk_bf16(v1[2], v1[3]);
                    *(u32x4*)(rowp + bj * HALF) = w; } }
    }
};
template <class Epi, class Sched, bool ALIGN_EPI = false, bool SP2 = false>
__device__ __forceinline__ void gemm_phase(PG8_LAS unsigned char* lds, const Gemm g, const Sched& S, const Epi& E) {
    int tid_raw_ = threadIdx.x; asm volatile("" : "+v"(tid_raw_));
    const int tid = tid_raw_, wid = __builtin_amdgcn_readfirstlane(tid >> 6), lane = tid & 63, wr = wid >> 2, wc = wid & 3, fr = lane & 15, fq = lane >> 4;
    const int K = g.K, nt = K / BK;
    unsigned voffA[2], voffB[2];
#pragma unroll
    for (int i = 0; i < 2; ++i) { int R, C; stage_rc(tid * 16 + i * 8192, R, C); const int Rb = Epi::PERM ? ((R & ~31) + perm32(R & 31)) : R;
        voffA[i] = (unsigned)(R * K + C) * 2u; voffB[i] = (unsigned)(Rb * K + C) * 2u; }
    const size_t kstep = (size_t)(BK * 2);
    const size_t hstep = (size_t)HALF * K * 2;
    const size_t tstep = 2 * hstep;
    const unsigned ldsw = (unsigned)wid * 1024u;
    const int aoff = lds_byte(wr * 64 + fr, fq * 8), boff = lds_byte(wc * 32 + fr, fq * 8);
#define PG8_SA(b, h) (((b) * 2 + (h)) * HTB)
#define PG8_SB(b, h) ((4 + (b) * 2 + (h)) * HTB)
#define PG8_STAGE(bufoff, gbase, voff) do { _Pragma("unroll") for (int _i = 0; _i < 2; ++_i) \
        __builtin_amdgcn_global_load_lds((const unsigned*)((const char*)(gbase) + (voff)[_i]), (PG8_LAS unsigned*)(lds + (bufoff) + ldsw + _i * 8192), 16, 0, 0); } while (0)
#define PG8_LDA(dst, b, h) do { _Pragma("unroll") for (int m = 0; m < 4; ++m) _Pragma("unroll") for (int k = 0; k < 2; ++k) dst[m][k] = *(const PG8_LAS bf16x8*)(lds + PG8_SA(b, h) + aoff + m * 2048 + k * 1024); } while (0)
#define PG8_LDB(dst, b, h) do { _Pragma("unroll") for (int n = 0; n < 2; ++n) _Pragma("unroll") for (int k = 0; k < 2; ++k) dst[n][k] = *(const PG8_LAS bf16x8*)(lds + PG8_SB(b, h) + boff + n * 2048 + k * 1024); } while (0)
#define PG8_MMA(ai, bj, At, Bt) do { __builtin_amdgcn_s_setprio(1); _Pragma("unroll") for (int m = 0; m < 4; ++m) _Pragma("unroll") for (int n = 0; n < 2; ++n) _Pragma("unroll") for (int k = 0; k < 2; ++k) \
        acc[ai][bj][m][n] = __builtin_amdgcn_mfma_f32_16x16x32_bf16(Bt[n][k], At[m][k], acc[ai][bj][m][n], 0, 0, 0); __builtin_amdgcn_s_setprio(0); } while (0)
#define PG8_WAIT_V(n) asm volatile("s_waitcnt vmcnt(" #n ")" ::: "memory")
#define PG8_WAIT_L(n) asm volatile("s_waitcnt lgkmcnt(" #n ")" ::: "memory")
#define PG8_BAR __builtin_amdgcn_s_barrier()
#define PG8_SCHED __builtin_amdgcn_sched_barrier(0)
    Unit cur, nxt; int ui = 0;
    if (!S.next(0, cur)) return;
    f32x4 acc[2][2][4][2];
#pragma unroll
    for (int a = 0; a < 2; ++a)
#pragma unroll
        for (int b = 0; b < 2; ++b)
#pragma unroll
            for (int m = 0; m < 4; ++m)
#pragma unroll
                for (int n = 0; n < 2; ++n) acc[a][b][m][n] = (f32x4){0.f, 0.f, 0.f, 0.f};
    bf16x8 At[4][2], B0[2][2], B1[2][2];
    const char* cA = (const char*)g.A + (size_t)cur.pm * tstep; const char* cB = (const char*)g.Bt + (size_t)cur.pn * tstep;
    S.a_ready(cur);
    if constexpr (SP2) {
        PG8_STAGE(PG8_SB(0, 0), cB, voffB); PG8_STAGE(PG8_SB(0, 1), cB + hstep, voffB); PG8_STAGE(PG8_SA(0, 0), cA, voffA); PG8_STAGE(PG8_SA(0, 1), cA + hstep, voffA);
        if (wr == 1) PG8_BAR;
        PG8_WAIT_V(2); PG8_BAR;
        PG8_STAGE(PG8_SB(1, 0), cB + kstep, voffB); PG8_STAGE(PG8_SA(1, 0), cA + kstep, voffA); PG8_STAGE(PG8_SB(1, 1), cB + hstep + kstep, voffB);
        PG8_WAIT_V(6); PG8_BAR;
    } else {
        PG8_STAGE(PG8_SB(0, 0), cB, voffB); PG8_STAGE(PG8_SA(0, 0), cA, voffA); PG8_STAGE(PG8_SB(0, 1), cB + hstep, voffB); PG8_STAGE(PG8_SA(0, 1), cA + hstep, voffA);
        if (wr == 1) PG8_BAR;
        PG8_WAIT_V(4); PG8_BAR;
        PG8_STAGE(PG8_SB(1, 0), cB + kstep, voffB); PG8_STAGE(PG8_SA(1, 0), cA + kstep, voffA); PG8_STAGE(PG8_SB(1, 1), cB + hstep + kstep, voffB);
        PG8_WAIT_V(6); PG8_BAR;
    }
    for (;;) {
        const bool has_next = S.next(ui + 1, nxt);
        const char* nA = has_next ? (const char*)g.A + (size_t)nxt.pm * tstep : cA; const char* nB = has_next ? (const char*)g.Bt + (size_t)nxt.pn * tstep : cB;
        for (int t = 0; t < nt; t += 2) {
            const bool last = (t == nt - 2);
            const char* a1 = cA + (size_t)(t + 1) * kstep;
            const char* a2 = last ? nA : cA + (size_t)(t + 2) * kstep; const char* b2 = last ? nB : cB + (size_t)(t + 2) * kstep;
            const char* a3 = a2 + kstep; const char* b3 = b2 + kstep;
            if (last && has_next) S.a_ready(nxt);
            if constexpr (SP2) {
            PG8_LDB(B0, 0, 0); PG8_LDB(B1, 0, 1); PG8_SCHED; PG8_LDA(At, 0, 0); PG8_STAGE(PG8_SA(1, 1), a1 + hstep, voffA);
            PG8_WAIT_V(8); PG8_WAIT_L(0); PG8_BAR; PG8_MMA(0, 0, At, B0); PG8_MMA(0, 1, At, B1); PG8_BAR; PG8_SCHED;
            PG8_LDA(At, 0, 1); PG8_STAGE(PG8_SB(0, 0), b2, voffB); PG8_STAGE(PG8_SB(0, 1), b2 + hstep, voffB); PG8_STAGE(PG8_SA(0, 0), a2, voffA);
            PG8_WAIT_V(8); PG8_WAIT_L(0); PG8_BAR; PG8_MMA(1, 0, At, B0); PG8_MMA(1, 1, At, B1); PG8_BAR; PG8_SCHED;
            PG8_LDB(B0, 1, 0); PG8_LDB(B1, 1, 1); PG8_SCHED; PG8_LDA(At, 1, 0); PG8_STAGE(PG8_SA(0, 1), a2 + hstep, voffA);
            PG8_WAIT_V(8); PG8_WAIT_L(0); PG8_BAR; PG8_MMA(0, 0, At, B0); PG8_MMA(0, 1, At, B1); PG8_BAR; PG8_SCHED;
            PG8_LDA(At, 1, 1); PG8_STAGE(PG8_SB(1, 0), b3, voffB); PG8_STAGE(PG8_SB(1, 1), b3 + hstep, voffB); PG8_STAGE(PG8_SA(1, 0), a3, voffA);
            PG8_WAIT_V(8); PG8_WAIT_L(0); PG8_BAR; PG8_MMA(1, 0, At, B0); PG8_MMA(1, 1, At, B1); PG8_BAR; PG8_SCHED;
            } else {
            PG8_LDB(B0, 0, 0); PG8_SCHED; PG8_LDA(At, 0, 0); PG8_STAGE(PG8_SA(1, 1), a1 + hstep, voffA);
            PG8_WAIT_L(8); PG8_BAR; PG8_WAIT_L(0); PG8_MMA(0, 0, At, B0); PG8_BAR; PG8_SCHED;
            PG8_LDB(B1, 0, 1); PG8_STAGE(PG8_SB(0, 0), b2, voffB);
            PG8_BAR; PG8_WAIT_L(0); PG8_MMA(0, 1, At, B1); PG8_BAR;
            PG8_LDA(At, 0, 1); PG8_STAGE(PG8_SA(0, 0), a2, voffA);
            PG8_BAR; PG8_WAIT_L(0); PG8_MMA(1, 0, At, B0); PG8_BAR; PG8_SCHED;
            PG8_STAGE(PG8_SB(0, 1), b2 + hstep, voffB);
            PG8_WAIT_V(6); PG8_BAR; PG8_MMA(1, 1, At, B1); PG8_BAR;
            PG8_LDB(B0, 1, 0); PG8_SCHED; PG8_LDA(At, 1, 0); PG8_STAGE(PG8_SA(0, 1), a2 + hstep, voffA);
            PG8_WAIT_L(8); PG8_BAR; PG8_WAIT_L(0); PG8_MMA(0, 0, At, B0); PG8_BAR; PG8_SCHED;
            PG8_LDB(B1, 1, 1); PG8_STAGE(PG8_SB(1, 0), b3, voffB);
            PG8_BAR; PG8_WAIT_L(0); PG8_MMA(0, 1, At, B1); PG8_BAR;
            PG8_LDA(At, 1, 1); PG8_STAGE(PG8_SA(1, 0), a3, voffA);
            PG8_BAR; PG8_WAIT_L(0); PG8_MMA(1, 0, At, B0); PG8_BAR; PG8_SCHED;
            PG8_STAGE(PG8_SB(1, 1), b3 + hstep, voffB);
            PG8_WAIT_V(6); PG8_BAR; PG8_MMA(1, 1, At, B1); PG8_BAR;
            }
        }
        if constexpr (ALIGN_EPI) { if (wr == 0) PG8_BAR; }
        if constexpr (!Epi::AFTER_DRAIN) { E(acc, cur, wr, wc, fr, fq); S.done(cur); }
        if (!has_next) break;
#pragma unroll
        for (int a = 0; a < 2; ++a)
#pragma unroll
            for (int b = 0; b < 2; ++b)
#pragma unroll
                for (int m = 0; m < 4; ++m)
#pragma unroll
                    for (int n = 0; n < 2; ++n) acc[a][b][m][n] = (f32x4){0.f, 0.f, 0.f, 0.f};
        cur = nxt; cA = nA; cB = nB; ++ui;
        if constexpr (ALIGN_EPI) { if (wr == 1) PG8_BAR; }
    }
    PG8_WAIT_V(0);
    if constexpr (!ALIGN_EPI) { if (wr == 0) PG8_BAR; }
    PG8_BAR;
    if constexpr (Epi::AFTER_DRAIN) { E.fused(acc, cur, wr, wc, fr, fq, lds, wid, lane); S.done(cur); }
#undef PG8_SA
#undef PG8_SB
#undef PG8_STAGE
#undef PG8_LDA
#undef PG8_LDB
#undef PG8_MMA
#undef PG8_WAIT_V
#undef PG8_WAIT_L
#undef PG8_BAR
#undef PG8_SCHED
}
}
#ifndef PG8_SP2
#define PG8_SP2 true
#endif
#define REP_P2 1
#define REP_SCAN 1
#define REP_P0 1
#ifndef PG8_ALIGN
#define PG8_ALIGN true
#endif
constexpr int BATCH = 2, SEQ = 8192, DM = 2048, MTOK = BATCH * SEQ, NMEM = 256, DFF = 8192;
constexpr int INW = 9992, N1 = 9984;
constexpr int C_QKVB = 0, C_ZB = 1536, C_QA = 2048, C_KA = 3072, C_VA = 3200, C_QC = 3328, C_GATE = 3840;
constexpr int O_AB = 2816;
constexpr float RMS_EPS = 1e-6f;
constexpr size_t MiB = 1u << 20;
constexpr size_t WS_CNT = 720896;
constexpr size_t WS_SSQ1 = 0, WS_SSQ2 = 65536, WS_AB = 131072, WS_GL = 655360, WS_MKV = 1 * MiB, WS_MEMN = 2 * MiB;
constexpr size_t WS_WINT = 4 * MiB, WS_WMKVT = 43 * MiB, WS_WSWAT = 47 * MiB, WS_WGDNT = 51 * MiB, WS_WXAT = 53 * MiB, WS_WOUTT = 55 * MiB;
constexpr size_t WS_P = 64 * MiB;
constexpr size_t WS_MERGED = 448 * MiB, WS_HB = 64 * MiB, WS_END = 512 * MiB;
constexpr size_t WS_GW = 376 * MiB, WS_GQD = 392 * MiB, WS_GKDT = 408 * MiB, WS_GQK = 424 * MiB, WS_GU = 432 * MiB;
constexpr size_t WS_W1T = 4 * MiB;
constexpr int NA = 2048;
constexpr size_t WS_HMID = 128 * MiB, WS_W2T = 384 * MiB;
constexpr int LDS_BYTES = 163840;

#define LAS __attribute__((address_space(3)))
typedef unsigned short bf16;
typedef short h8 __attribute__((ext_vector_type(8)));
typedef float v4f __attribute__((ext_vector_type(4)));
typedef float v16f __attribute__((ext_vector_type(16)));
typedef unsigned v4u __attribute__((ext_vector_type(4)));
typedef unsigned v2u __attribute__((ext_vector_type(2)));
#define MFMA32(a, b, c) __builtin_amdgcn_mfma_f32_32x32x16_bf16((a), (b), (c), 0, 0, 0)
__device__ __forceinline__ unsigned pk2(float lo, float hi) { return pg8::cvt_pk_bf16(lo, hi); }
__device__ __forceinline__ bf16 f2bf(float f) { return (bf16)(pk2(f, 0.f) & 0xffffu); }
__device__ __forceinline__ float bflo(unsigned w) { return __uint_as_float(w << 16); }
__device__ __forceinline__ float bfhi(unsigned w) { return __uint_as_float(w & 0xffff0000u); }
__device__ __forceinline__ int swap23(int p) { return (p & ~12) | ((p & 4) << 1) | ((p & 8) >> 1); }
__device__ __forceinline__ int crow(int r, int hi) { return (r & 3) + 8 * (r >> 2) + 4 * hi; }
__device__ __forceinline__ float wave_sum(float v) {
#pragma unroll
    for (int o = 1; o < 64; o <<= 1) v += __shfl_xor(v, o);
    return v;
}
#define LDS_BARRIER() asm volatile("s_waitcnt lgkmcnt(0)\n\ts_barrier" ::: "memory")
__device__ __forceinline__ float sigmoidf_(float x) { return __builtin_amdgcn_rcpf(1.0f + __expf(-x)); }

__device__ __forceinline__ void tr_load(float (&v)[32], const float* W, int ldw, int col0src, int kb, int nb, int lane) {
    const int k0 = 64 * kb, n0 = 32 * nb;
#pragma unroll
    for (int i = 0; i < 32; ++i) v[i] = W[(size_t)(k0 + 2 * i + (lane >> 5)) * ldw + col0src + n0 + (lane & 31)];
}
__device__ __forceinline__ void tr_store(const float (&v)[32], const float* kscale, int K, bf16* WT, LAS float* scr, int kb, int nb, int lane) {
    const int k0 = 64 * kb, n0 = 32 * nb;
#pragma unroll
    for (int i = 0; i < 32; ++i) { const int kk = 2 * i + (lane >> 5); float x = v[i]; if (kscale) x *= kscale[k0 + kk]; scr[kk * 33 + (lane & 31)] = x; }
    asm volatile("s_waitcnt lgkmcnt(0)" ::: "memory");
    const int c = lane & 7;
#pragma unroll
    for (int j = 0; j < 4; ++j) { const int n = (lane >> 3) + 8 * j; const LAS float* sp = scr + (8 * c) * 33 + n;
        v4u o; o.x = pk2(sp[0 * 33], sp[1 * 33]); o.y = pk2(sp[2 * 33], sp[3 * 33]); o.z = pk2(sp[4 * 33], sp[5 * 33]); o.w = pk2(sp[6 * 33], sp[7 * 33]);
        *(v4u*)(WT + (size_t)(n0 + n) * K + k0 + 8 * c) = o; }
    asm volatile("s_waitcnt lgkmcnt(0)" ::: "memory");
}
__device__ __forceinline__ int win_csrc(bool skip_ab, int nb) { if (!skip_ab) return 0; const int c0 = nb * 32; return (c0 < 1536) ? 1280 : (c0 < 2048) ? (2824 - 1536) : (c0 < 3328) ? -2048 : 8; }
__device__ __forceinline__ void transpose_matrix(const float* W, int ldw, int K, int N, bool skip_ab, const float* kscale, bf16* WT, LAS float* scr, int gw, int NGW, int& off, int lane) {
    const int nblk = N / 32, items = (K / 64) * nblk;
    int start = (gw - (off % NGW)); if (start < 0) start += NGW;
    off += items;
    if (start >= items) return;
    float va[32], vb[32];
    tr_load(va, W, ldw, win_csrc(skip_ab, start % nblk), start / nblk, start % nblk, lane);
    for (int it = start; it < items; it += 2 * NGW) {
        const int it1 = it + NGW, it2 = it + 2 * NGW;
        if (it1 < items) tr_load(vb, W, ldw, win_csrc(skip_ab, it1 % nblk), it1 / nblk, it1 % nblk, lane);
        tr_store(va, kscale, K, WT, scr, it / nblk, it % nblk, lane);
        if (it1 < items) {
            if (it2 < items) tr_load(va, W, ldw, win_csrc(skip_ab, it2 % nblk), it2 / nblk, it2 % nblk, lane);
            tr_store(vb, kscale, K, WT, scr, it1 / nblk, it1 % nblk, lane);
        }
    }
}
__device__ __forceinline__ void rms_row_to_bf16(v4f (&v)[8], const float* g, bf16* orow, const LAS float* wabt, float* ab, int lane) {
    const v4f* gr = (const v4f*)g + lane;
    float s = 0.f;
#pragma unroll
    for (int j = 0; j < 8; ++j) s += (v[j].x * v[j].x + v[j].y * v[j].y) + (v[j].z * v[j].z + v[j].w * v[j].w);
    const float rstd = rsqrtf(wave_sum(s) * (1.f / DM) + RMS_EPS);
#pragma unroll
    for (int j = 0; j < 8; ++j) { v[j] = v[j] * rstd * gr[64 * j]; }
    v2u* o8 = (v2u*)orow + lane;
#pragma unroll
    for (int j = 0; j < 8; ++j) { v2u w; w.x = pk2(v[j].x, v[j].y); w.y = pk2(v[j].z, v[j].w); o8[64 * j] = w; }
    if (ab) {
        float a[8];
#pragma unroll
        for (int c = 0; c < 8; ++c) { float t = 0.f;
#pragma unroll
            for (int j = 0; j < 8; ++j) { const v4f w = *(const LAS v4f*)(wabt + c * DM + 256 * j + 4 * lane); t += (v[j].x * w.x + v[j].y * w.y) + (v[j].z * w.z + v[j].w * w.w); }
            a[c] = t; asm volatile("" ::: "memory"); }
        const bool b0 = lane & 1, b1 = lane & 2, b2 = lane & 4;
#pragma unroll
        for (int c = 0; c < 4; ++c) { const float send = b0 ? a[c] : a[c + 4], keep = b0 ? a[c + 4] : a[c]; a[c] = keep + __shfl_xor(send, 1); }
#pragma unroll
        for (int c = 0; c < 2; ++c) { const float send = b1 ? a[c] : a[c + 2], keep = b1 ? a[c + 2] : a[c]; a[c] = keep + __shfl_xor(send, 2); }
        { const float send = b2 ? a[0] : a[1], keep = b2 ? a[1] : a[0]; a[0] = keep + __shfl_xor(send, 4); }
        a[0] += __shfl_xor(a[0], 8); a[0] += __shfl_xor(a[0], 16); a[0] += __shfl_xor(a[0], 32);
        if (lane < 8) ab[4 * (lane & 1) + 2 * ((lane >> 1) & 1) + ((lane >> 2) & 1)] = a[0];
    }
}
__device__ __forceinline__ void rms_rows(const float* x, const float* g, bf16* o, const LAS float* wabt, float* ab, int first, int stride, int nrows, int lane) {
    v4f cur[8], nxt[8];
    if (first < nrows) {
#pragma unroll
        for (int j = 0; j < 8; ++j) cur[j] = ((const v4f*)(x + (size_t)first * DM) + lane)[64 * j];
    }
    for (int m = first; m < nrows; m += stride) {
        const bool more = (m + stride < nrows);
        if (more) {
#pragma unroll
            for (int j = 0; j < 8; ++j) nxt[j] = ((const v4f*)(x + (size_t)(m + stride) * DM) + lane)[64 * j];
        }
        rms_row_to_bf16(cur, g, o + (size_t)m * DM, wabt, ab ? ab + (size_t)m * 8 : nullptr, lane);
#pragma unroll
        for (int j = 0; j < 8; ++j) cur[j] = nxt[j];
    }
}

template <int D, bool SWA>
__device__ __forceinline__ void attn_wave(const LAS bf16* Ks, const LAS bf16* VTs, const h8 (&qf)[D / 16], bf16* Og, int ldo,
                                          int kt_lo, int kt_hi, int qi0, bool has_prev, float scale, float sink, int lane) {
    constexpr int KP = D + 8, VP = 264, NS = D / 16, ND = D / 32;
    const int lr = lane & 31, hi = lane >> 5;
    v16f o[ND];
#pragma unroll
    for (int d = 0; d < ND; ++d)
#pragma unroll
        for (int r = 0; r < 16; ++r) o[d][r] = 0.f;
    float m = SWA ? sink : -1e30f, l = SWA ? 1.f : 0.f;
    const int qi = qi0 + lr;
    for (int kt = kt_lo; kt < kt_hi; ++kt) {
        v16f p;
#pragma unroll
        for (int r = 0; r < 16; ++r) p[r] = 0.f;
#pragma unroll
        for (int s = 0; s < NS; ++s) { const h8 a = *(const LAS h8*)(Ks + (32 * kt + lr) * KP + 16 * s + 8 * hi); p = MFMA32(a, qf[s], p); }
        float tmax = -INFINITY;
#pragma unroll
        for (int r = 0; r < 16; ++r) { float v = p[r] * scale;
            if (SWA) { const int kv = 32 * kt + crow(r, hi); const bool ok = (kv > qi) && (kv <= qi + 128) && (has_prev || kv >= 128); v = ok ? v : -INFINITY; }
            p[r] = v; tmax = fmaxf(tmax, v); }
        tmax = fmaxf(tmax, __shfl_xor(tmax, 32));
        const float mnew = fmaxf(m, tmax), alpha = __expf(m - mnew);
        float ps = 0.f;
#pragma unroll
        for (int r = 0; r < 16; ++r) { p[r] = __expf(p[r] - mnew); ps += p[r]; }
        ps += __shfl_xor(ps, 32);
        l = l * alpha + ps; m = mnew;
#pragma unroll
        for (int d = 0; d < ND; ++d)
#pragma unroll
            for (int r = 0; r < 16; ++r) o[d][r] *= alpha;
        h8 pb[2];
#pragma unroll
        for (int j = 0; j < 2; ++j) { v4u w; w.x = pk2(p[8 * j + 0], p[8 * j + 1]); w.y = pk2(p[8 * j + 2], p[8 * j + 3]); w.z = pk2(p[8 * j + 4], p[8 * j + 5]); w.w = pk2(p[8 * j + 6], p[8 * j + 7]); pb[j] = __builtin_bit_cast(h8, w); }
#pragma unroll
        for (int d = 0; d < ND; ++d)
#pragma unroll
            for (int j = 0; j < 2; ++j) { const LAS bf16* vp = VTs + (32 * d + lr) * VP + 32 * kt + 16 * j + 4 * hi;
                const v2u lo = *(const LAS v2u*)vp, hh = *(const LAS v2u*)(vp + 8);
                const v4u aw = (v4u){lo.x, lo.y, hh.x, hh.y};
                o[d] = MFMA32(__builtin_bit_cast(h8, aw), pb[j], o[d]); }
    }
    const float inv = 1.0f / l;
#pragma unroll
    for (int d = 0; d < ND; ++d)
#pragma unroll
        for (int rg = 0; rg < 4; ++rg) { v2u w; w.x = pk2(o[d][4 * rg] * inv, o[d][4 * rg + 1] * inv); w.y = pk2(o[d][4 * rg + 2] * inv, o[d][4 * rg + 3] * inv);
            *(v2u*)(Og + 32 * d + 8 * rg + 4 * hi) = w; }
}
__device__ __forceinline__ void put8T(LAS bf16* VTs, int d0, int row, v4u v) {
    VTs[(d0 + 0) * 264 + row] = (bf16)(v.x & 0xffffu); VTs[(d0 + 1) * 264 + row] = (bf16)(v.x >> 16);
    VTs[(d0 + 2) * 264 + row] = (bf16)(v.y & 0xffffu); VTs[(d0 + 3) * 264 + row] = (bf16)(v.y >> 16);
    VTs[(d0 + 4) * 264 + row] = (bf16)(v.z & 0xffffu); VTs[(d0 + 5) * 264 + row] = (bf16)(v.z >> 16);
    VTs[(d0 + 6) * 264 + row] = (bf16)(v.w & 0xffffu); VTs[(d0 + 7) * 264 + row] = (bf16)(v.w >> 16);
}
__device__ __forceinline__ void swa_unit(int unit, const bf16* P, bf16* YA, const float* sinks, LAS unsigned char* lds, int tid) {
    const int nb = unit & 63, kvh = (unit >> 6) & 1, b = unit >> 7, lane = tid & 63, wave = tid >> 6, lr = lane & 31, hi = lane >> 5;
    LAS bf16* Ks = (LAS bf16*)lds; LAS bf16* VTs = (LAS bf16*)(lds + 256 * 72 * 2);
    const long rowbase = (long)b * SEQ + nb * 128 - 128;
    const int head = kvh * 8 + wave; const float sink = sinks[head];
    h8 qA[4], qB[4];
#define SWA_LOADQ(dst, qt_) do { _Pragma("unroll") for (int s_ = 0; s_ < 4; ++s_) dst[s_] = *(const h8*)(P + ((size_t)b * SEQ + nb * 128 + (qt_) * 32 + lr) * N1 + C_QA + head * 64 + 16 * s_ + 8 * hi); } while (0)
    SWA_LOADQ(qA, 0);
#pragma unroll
    for (int i = 0; i < 4; ++i) { const int id = tid + 512 * i, row = id & 255, ch = id >> 8;
        v4u kv = (v4u){0u, 0u, 0u, 0u}, vv = (v4u){0u, 0u, 0u, 0u};
        if (nb > 0 || row >= 128) { const bf16* src = P + (size_t)(rowbase + row) * N1; kv = *(const v4u*)(src + C_KA + kvh * 64 + ch * 8); vv = *(const v4u*)(src + C_VA + kvh * 64 + ch * 8); }
        *(LAS v4u*)(Ks + row * 72 + ch * 8) = kv; put8T(VTs, ch * 8, row, vv); }
    LDS_BARRIER();
#pragma unroll 1
    for (int qp = 0; qp < 2; ++qp) { const int qt = 2 * qp; const size_t tok = (size_t)b * SEQ + nb * 128 + qt * 32;
        SWA_LOADQ(qB, qt + 1);
        attn_wave<64, true>(Ks, VTs, qA, YA + (tok + lr) * 1024 + head * 64, 1024, qt, qt + 5, qt * 32, nb > 0, 0.125f, sink, lane);
        if (qp == 0) SWA_LOADQ(qA, 2);
        attn_wave<64, true>(Ks, VTs, qB, YA + (tok + 32 + lr) * 1024 + head * 64, 1024, qt + 1, qt + 6, (qt + 1) * 32, nb > 0, 0.125f, sink, lane); }
    LDS_BARRIER();
#undef SWA_LOADQ
}
__device__ __forceinline__ void xa_unit(int unit, const bf16* P, const bf16* MKV, bf16* YC, LAS unsigned char* lds, int tid) {
    const int qblk = unit & 31, h = (unit >> 5) & 3, b = unit >> 7, lane = tid & 63, wave = tid >> 6, lr = lane & 31, hi = lane >> 5;
    LAS bf16* Ks = (LAS bf16*)lds; LAS bf16* VTs = (LAS bf16*)(lds + 256 * 136 * 2);
    const size_t tok = (size_t)b * SEQ + qblk * 256 + wave * 32;
    h8 qf[8];
#pragma unroll
    for (int s = 0; s < 8; ++s) qf[s] = *(const h8*)(P + (tok + lr) * N1 + C_QC + h * 128 + 16 * s + 8 * hi);
#pragma unroll
    for (int i = 0; i < 8; ++i) { const int id = tid + 512 * i, row = id & 255, ch = id >> 8;
        const bf16* src = MKV + (size_t)(b * NMEM + row) * 1024 + h * 128 + ch * 8;
        const v4u kv = *(const v4u*)src, vv = *(const v4u*)(src + 512);
        *(LAS v4u*)(Ks + row * 136 + ch * 8) = kv; put8T(VTs, ch * 8, row, vv); }
    LDS_BARRIER();
    attn_wave<128, false>(Ks, VTs, qf, YC + (tok + lr) * 512 + h * 128, 512, 0, 8, 0, true, 0.08838834764831845f, 0.f, lane);
    LDS_BARRIER();
}

__device__ __forceinline__ void gdn_prep_unit(int uidx, const bf16* P, const float* AB, const float* conv_w, const float* a_log, const float* dt_bias,
                                              bf16* Wg, bf16* QDg, bf16* KDTg, bf16* QKg, bf16* Ug, float* GLg, LAS unsigned char* lds, int tid) {
    const int bh = uidx >> 7, n = uidx & 127, b = bh >> 2, h = bh & 3, slot = n * 8 + bh;
    LAS float* qs = (LAS float*)lds; LAS float* ks = qs + 64 * 132; LAS float* vs = ks + 64 * 132; LAS float* Lm = vs + 64 * 132; LAS float* gc = Lm + 64 * 64; LAS float* bt = gc + 64;
    const size_t tok0 = (size_t)b * SEQ + n * 64;
    if (tid < 384) {
        const int cp = tid % 192, seg = tid / 192, which = cp >> 6, cc = (cp & 63) * 2;
        const int col = C_QKVB + which * 512 + h * 128 + cc, cw = which * 512 + h * 128 + cc;
        const float wa0 = conv_w[cw], wa1 = conv_w[1536 + cw], wa2 = conv_w[3072 + cw], wa3 = conv_w[4608 + cw];
        const float wb0 = conv_w[cw + 1], wb1 = conv_w[1536 + cw + 1], wb2 = conv_w[3072 + cw + 1], wb3 = conv_w[4608 + cw + 1];
        LAS float* dst = qs + which * (64 * 132);
        const int t0 = seg * 32;
        unsigned xw[35];
#pragma unroll
        for (int i = 0; i < 35; ++i) { const int tt = t0 - 3 + i; xw[i] = (n * 64 + tt >= 0) ? *(const unsigned*)(P + (tok0 + tt) * N1 + col) : 0u; }
#pragma unroll
        for (int i = 0; i < 32; ++i) { const int t = t0 + i;
            const float ya = wa0 * bflo(xw[i]) + wa1 * bflo(xw[i + 1]) + wa2 * bflo(xw[i + 2]) + wa3 * bflo(xw[i + 3]);
            const float yb = wb0 * bfhi(xw[i]) + wb1 * bfhi(xw[i + 1]) + wb2 * bfhi(xw[i + 2]) + wb3 * bfhi(xw[i + 3]);
            typedef float f2_t __attribute__((ext_vector_type(2))); *(LAS f2_t*)(dst + t * 132 + cc) = (f2_t){ya * sigmoidf_(ya), yb * sigmoidf_(yb)}; }
    } else if (tid < 448) {
        const int t = tid - 384;
        const float a = AB[(tok0 + t) * 8 + h], bb = AB[(tok0 + t) * 8 + 4 + h];
        const float x = a + dt_bias[h], sp = x > 20.f ? x : log1pf(expf(x));
        float g = -expf(a_log[h]) * sp;
#pragma unroll
        for (int o = 1; o < 64; o <<= 1) { const float v = __shfl_up(g, o); if (t >= o) g += v; }
        gc[t] = g; bt[t] = 1.0f / (1.0f + expf(-bb));
    }
    LDS_BARRIER();
    { const int row = tid >> 2, part = tid & 3; LAS float* base = (row < 64 ? qs : ks) + (row & 63) * 132; float ss = 0.f;
#pragma unroll
      for (int i = 0; i < 32; ++i) { const float v = base[part + 4 * i]; ss += v * v; }
      ss += __shfl_xor(ss, 1); ss += __shfl_xor(ss, 2);
      const float sc = rsqrtf(ss + 1e-6f) * (row < 64 ? 0.08838834764831845f : 1.f);
#pragma unroll
      for (int i = 0; i < 32; ++i) base[part + 4 * i] *= sc; }
    LDS_BARRIER();
    { const int ib = tid >> 4, jb = tid & 15;
      float kk[2][4], qk[2][4];
#pragma unroll
      for (int y = 0; y < 2; ++y)
#pragma unroll
          for (int x = 0; x < 4; ++x) { kk[y][x] = 0.f; qk[y][x] = 0.f; }
#pragma unroll 2
      for (int d4 = 0; d4 < 32; ++d4) {
          v4f ki[2], qi[2], kj[4];
#pragma unroll
          for (int y = 0; y < 2; ++y) { ki[y] = *(const LAS v4f*)(ks + (ib + 32 * y) * 132 + 4 * d4); qi[y] = *(const LAS v4f*)(qs + (ib + 32 * y) * 132 + 4 * d4); }
#pragma unroll
          for (int x = 0; x < 4; ++x) kj[x] = *(const LAS v4f*)(ks + (jb + 16 * x) * 132 + 4 * d4);
#pragma unroll
          for (int y = 0; y < 2; ++y)
#pragma unroll
              for (int x = 0; x < 4; ++x) { kk[y][x] += (ki[y].x * kj[x].x + ki[y].y * kj[x].y) + (ki[y].z * kj[x].z + ki[y].w * kj[x].w);
                                            qk[y][x] += (qi[y].x * kj[x].x + qi[y].y * kj[x].y) + (qi[y].z * kj[x].z + qi[y].w * kj[x].w); }
      }
#pragma unroll
      for (int y = 0; y < 2; ++y)
#pragma unroll
          for (int x = 0; x < 4; ++x) { const int i = ib + 32 * y, j = jb + 16 * x;
              const float dec = (j <= i) ? __expf(gc[i] - gc[j]) : 0.f;
              Lm[j * 64 + i] = (j < i) ? bt[i] * kk[y][x] * dec : 0.f;
              QKg[(size_t)slot * 4096 + i * 64 + swap23(j)] = f2bf(qk[y][x] * dec); }
    }
    LDS_BARRIER();
    { const float gl = gc[63];
#pragma unroll 4
      for (int i = 0; i < 16; ++i) { const int e = tid + 512 * i, row = e >> 7, d = e & 127; QDg[(size_t)slot * 8192 + e] = f2bf(qs[row * 132 + swap23(d)] * __expf(gc[row])); }
#pragma unroll 4
      for (int i = 0; i < 16; ++i) { const int e = tid + 512 * i, d = e >> 6, r = swap23(e & 63); KDTg[(size_t)slot * 8192 + e] = f2bf(ks[r * 132 + d] * __expf(gl - gc[r])); }
      if (tid == 0) GLg[slot] = __expf(gl); }
    LDS_BARRIER();
    if (tid < 256) {
        const int col = tid; const bool isv = col < 128; LAS float* src = isv ? vs + col : ks + (col - 128);
#pragma unroll 1
        for (int ib = 0; ib < 8; ++ib) {
            float r[8];
#pragma unroll
            for (int e = 0; e < 8; ++e) { const int i = 8 * ib + e; float v = src[i * 132] * bt[i]; if (!isv) v *= __expf(gc[i]); r[e] = v; }
#pragma unroll 2
            for (int j = 0; j < 8 * ib; ++j) { const float sv = src[j * 132]; const v4f l0 = *(const LAS v4f*)(Lm + j * 64 + 8 * ib), l1 = *(const LAS v4f*)(Lm + j * 64 + 8 * ib + 4);
                r[0] -= l0.x * sv; r[1] -= l0.y * sv; r[2] -= l0.z * sv; r[3] -= l0.w * sv; r[4] -= l1.x * sv; r[5] -= l1.y * sv; r[6] -= l1.z * sv; r[7] -= l1.w * sv; }
#pragma unroll
            for (int e = 1; e < 8; ++e)
#pragma unroll
                for (int f = 0; f < e; ++f) r[e] -= Lm[(8 * ib + f) * 64 + 8 * ib + e] * r[f];
#pragma unroll
            for (int e = 0; e < 8; ++e) src[(8 * ib + e) * 132] = r[e];
        }
    }
    LDS_BARRIER();
#pragma unroll
    for (int i = 0; i < 2; ++i) { const int e = tid + 512 * i, w_ = e >> 8, j_ = (e >> 6) & 3, l_ = e & 63, lr_ = l_ & 31, hi_ = l_ >> 5, dv = 32 * w_ + lr_;
        const int c0 = 32 * (j_ >> 1) + 16 * (j_ & 1) + 4 * hi_;
        const LAS float* sp = vs + c0 * 132 + dv;
        v4u w; w.x = pk2(sp[0], sp[132]); w.y = pk2(sp[2 * 132], sp[3 * 132]); w.z = pk2(sp[8 * 132], sp[9 * 132]); w.w = pk2(sp[10 * 132], sp[11 * 132]);
        *(v4u*)(Ug + (size_t)slot * 8192 + (size_t)e * 8) = w; }
#pragma unroll
    for (int i = 0; i < 2; ++i) { const int e8 = tid + 512 * i, row = e8 >> 4, c8 = (e8 & 15) * 8, o0 = (c8 & ~15) + 4 * ((c8 >> 3) & 1);
        const v4f x0 = *(const LAS v4f*)(ks + row * 132 + o0), x1 = *(const LAS v4f*)(ks + row * 132 + o0 + 8);
        v4u w; w.x = pk2(x0.x, x0.y); w.y = pk2(x0.z, x0.w); w.z = pk2(x1.x, x1.y); w.w = pk2(x1.z, x1.w); *(v4u*)(Wg + (size_t)slot * 8192 + row * 128 + c8) = w; }
    LDS_BARRIER();
}

__device__ __forceinline__ void wg_publish_add(unsigned* word) {
    asm volatile("s_waitcnt vmcnt(0)" ::: "memory");
    __syncthreads();
    if (threadIdx.x == 0) { __builtin_amdgcn_fence(__ATOMIC_RELEASE, "agent"); asm volatile("s_waitcnt vmcnt(0)" ::: "memory"); __hip_atomic_fetch_add(word, 1u, __ATOMIC_RELAXED, __HIP_MEMORY_SCOPE_AGENT); }
}
__device__ __forceinline__ void wave_wait_ge(unsigned* word, unsigned want) {
    while (__hip_atomic_load(word, __ATOMIC_RELAXED, __HIP_MEMORY_SCOPE_AGENT) < want) __builtin_amdgcn_s_sleep(2);
    __builtin_amdgcn_fence(__ATOMIC_ACQUIRE, "agent");
    asm volatile("s_waitcnt vmcnt(0)" ::: "memory");
}
__device__ __forceinline__ h8 pack8(const v16f& x, int j) { v4u w; w.x = pk2(x[8 * j], x[8 * j + 1]); w.y = pk2(x[8 * j + 2], x[8 * j + 3]); w.z = pk2(x[8 * j + 4], x[8 * j + 5]); w.w = pk2(x[8 * j + 6], x[8 * j + 7]); return __builtin_bit_cast(h8, w); }
__device__ __forceinline__ void gdn_scan(int bh, const bf16* P, bf16* YB, const float* norm_w, const bf16* Wg, const bf16* QDg, const bf16* KDTg, const bf16* QKg, const bf16* Ug, const float* GLg, unsigned* flags,
                                         LAS unsigned char* lds, int tid) {
    constexpr int OPB = 62464;
    const int b = bh >> 2, h = bh & 3, lane = tid & 63, wave = __builtin_amdgcn_readfirstlane(tid >> 6), lr = lane & 31, hi = lane >> 5;
    LAS bf16* Ob = (LAS bf16*)(lds + 2 * OPB);
#define SLOT(nn) ((size_t)(nn) * 8 + (size_t)bh)
    LAS float* gll = (LAS float*)(lds + 2 * OPB + 2 * 64 * 136 * 2 + 512);
    if (wave == 4) { wave_wait_ge(flags + SLOT(0), 1u); wave_wait_ge(flags + SLOT(1), 1u); wave_wait_ge(flags + SLOT(2), 1u); wave_wait_ge(flags + SLOT(3), 1u); if (lane < 4) gll[lane] = GLg[SLOT(lane)]; }
    LDS_BARRIER();
    if (wave < 4) {
        const int w = wave;
        v16f sacc[4];
#pragma unroll
        for (int t = 0; t < 4; ++t)
#pragma unroll
            for (int r = 0; r < 16; ++r) sacc[t][r] = 0.f;
        v4u uA[4], uB[4];
#define SC_LOADU(dst, nn) do { const bf16* up_ = Ug + SLOT(nn) * 8192 + (size_t)(w * 256 + lane) * 8; \
        _Pragma("unroll") for (int q_ = 0; q_ < 4; ++q_) dst[q_] = *(const v4u*)(up_ + 512 * q_); } while (0)
        SC_LOADU(uA, 0); SC_LOADU(uB, 1);
        LDS_BARRIER();
#define SC_CSTEP(nn, UC) do { int n_ = (nn); asm volatile("" : "+s"(n_));     \
            LAS const bf16* Wl = (LAS const bf16*)(lds + (n_ & 1) * OPB); LAS const bf16* QDl = Wl + 64 * 136; LAS const bf16* KDTl = QDl + 64 * 136; LAS const bf16* QKl = KDTl + 128 * 72; \
            const float gl = gll[n_]; \
            h8 sB[8]; \
            _Pragma("unroll") for (int t = 0; t < 4; ++t) { sB[2 * t] = pack8(sacc[t], 0); sB[2 * t + 1] = pack8(sacc[t], 1); } \
            v16f vn[2]; \
            _Pragma("unroll") for (int mt = 0; mt < 2; ++mt) { \
                _Pragma("unroll") for (int r = 0; r < 16; ++r) vn[mt][r] = 0.f; \
                _Pragma("unroll") for (int ks = 0; ks < 8; ++ks) { const h8 a = *(const LAS h8*)(Wl + (32 * mt + lr) * 136 + 16 * ks + 8 * hi); vn[mt] = MFMA32(a, sB[ks], vn[mt]); } } \
            h8 vB[4]; \
            _Pragma("unroll") for (int mt = 0; mt < 2; ++mt) { \
                _Pragma("unroll") for (int rg = 0; rg < 4; ++rg) { const v4u u4_ = UC[2 * mt + (rg >> 1)]; const v2u uu = (rg & 1) ? (v2u){u4_.z, u4_.w} : (v2u){u4_.x, u4_.y}; \
                    vn[mt][4 * rg] = bflo(uu.x) - vn[mt][4 * rg]; vn[mt][4 * rg + 1] = bfhi(uu.x) - vn[mt][4 * rg + 1]; vn[mt][4 * rg + 2] = bflo(uu.y) - vn[mt][4 * rg + 2]; vn[mt][4 * rg + 3] = bfhi(uu.y) - vn[mt][4 * rg + 3]; } \
                vB[2 * mt] = pack8(vn[mt], 0); vB[2 * mt + 1] = pack8(vn[mt], 1); } \
            if (n_ + 2 < 128) SC_LOADU(UC, n_ + 2); \
            LAS bf16* ObW = Ob + (n_ & 1) * (64 * 136);                 \
            _Pragma("unroll") for (int mt = 0; mt < 2; ++mt) { v16f o; \
                _Pragma("unroll") for (int r = 0; r < 16; ++r) o[r] = 0.f; \
                _Pragma("unroll") for (int ks = 0; ks < 8; ++ks) { const h8 a = *(const LAS h8*)(QDl + (32 * mt + lr) * 136 + 16 * ks + 8 * hi); o = MFMA32(a, sB[ks], o); } \
                _Pragma("unroll") for (int ks = 0; ks < 4; ++ks) { const h8 a = *(const LAS h8*)(QKl + (32 * mt + lr) * 72 + 16 * ks + 8 * hi); o = MFMA32(a, vB[ks], o); } \
                _Pragma("unroll") for (int r = 0; r < 16; ++r) ObW[(32 * mt + crow(r, hi)) * 136 + 32 * w + lr] = f2bf(o[r]); } \
            _Pragma("unroll") for (int t = 0; t < 4; ++t) { \
                _Pragma("unroll") for (int r = 0; r < 16; ++r) sacc[t][r] *= gl; \
                _Pragma("unroll") for (int ks = 0; ks < 4; ++ks) { const h8 a = *(const LAS h8*)(KDTl + (32 * t + lr) * 72 + 16 * ks + 8 * hi); sacc[t] = MFMA32(a, vB[ks], sacc[t]); } } \
            LDS_BARRIER();                                             \
        } while (0)
#pragma unroll 1
        for (int n = 0; n < 128; n += 2) { SC_CSTEP(n, uA); SC_CSTEP(n + 1, uB); }
        LDS_BARRIER();
#undef SC_LOADU
#undef SC_CSTEP
    } else {
        const int t2 = tid - 256, c = t2 >> 2, q = t2 & 3;
        struct OpRegs { v4u w[4], qd[4], kdt[4], qk[2]; };
        float glv = 0.f;
        OpRegs RA, RB;
#define LDG16(base, off32) (*(const v4u*)((const char*)(base) + (unsigned)(off32)))
#define SC_LOAD(R, nn) do { const size_t ub_ = SLOT(nn) * 8192; const bf16* wb_ = Wg + ub_; const bf16* qdb_ = QDg + ub_; const bf16* kb_ = KDTg + ub_; const bf16* qkb_ = QKg + SLOT(nn) * 4096; \
        _Pragma("unroll") for (int i_ = 0; i_ < 4; ++i_) { R.w[i_] = LDG16(wb_, o16 + 4096u * i_); R.qd[i_] = LDG16(qdb_, o16 + 4096u * i_); R.kdt[i_] = LDG16(kb_, o16 + 4096u * i_); } \
        _Pragma("unroll") for (int i_ = 0; i_ < 2; ++i_) R.qk[i_] = LDG16(qkb_, o16 + 4096u * i_); } while (0)
#define SC_STORE(R, buf) do { LAS bf16* Wl_ = (LAS bf16*)(lds + (buf) * OPB); LAS bf16* QDl_ = Wl_ + 64 * 136; LAS bf16* KDTl_ = QDl_ + 64 * 136; LAS bf16* QKl_ = KDTl_ + 128 * 72; \
        _Pragma("unroll") for (int i_ = 0; i_ < 4; ++i_) { const int id_ = t2 + 256 * i_; *(LAS v4u*)(Wl_ + (id_ >> 4) * 136 + (id_ & 15) * 8) = R.w[i_]; *(LAS v4u*)(QDl_ + (id_ >> 4) * 136 + (id_ & 15) * 8) = R.qd[i_]; *(LAS v4u*)(KDTl_ + (id_ >> 3) * 72 + (id_ & 7) * 8) = R.kdt[i_]; } \
        _Pragma("unroll") for (int i_ = 0; i_ < 2; ++i_) { const int id_ = t2 + 256 * i_; *(LAS v4u*)(QKl_ + (id_ >> 3) * 72 + (id_ & 7) * 8) = R.qk[i_]; } } while (0)
        const unsigned o16 = (unsigned)t2 * 16u, yoff = ((unsigned)c * 512u + 32u * q) * 2u;
        LAS float* nwl = (LAS float*)(lds + 2 * OPB + 2 * 64 * 136 * 2);
        if (t2 < 128) nwl[t2] = norm_w[t2];
        SC_LOAD(RA, 0); SC_STORE(RA, 0); asm volatile("" ::: "memory"); SC_LOAD(RA, 1); SC_LOAD(RB, 2);
        LDS_BARRIER();
#define SC_LITER(nn, R) do { int n_ = (nn); asm volatile("" : "+s"(n_)); \
            unsigned fl_ = 1u; \
            if (wave == 4) { if (n_ >= 1 && n_ + 3 < 128 && lane == 0) gll[n_ + 3] = glv; \
                             if (n_ + 4 < 128) fl_ = __hip_atomic_load(flags + SLOT(n_ + 4), __ATOMIC_RELAXED, __HIP_MEMORY_SCOPE_AGENT); }     \
            v4u ov[4]; \
            bf16* yb_ = YB + ((size_t)b * SEQ + (size_t)(n_ - 1) * 64) * 512 + h * 128; \
            if (n_ >= 1) { _Pragma("unroll") for (int i = 0; i < 4; ++i) ov[i] = *(const LAS v4u*)(Ob + ((n_ - 1) & 1) * (64 * 136) + c * 136 + 32 * q + 8 * i); } \
            if (n_ == 128) LDS_BARRIER();                              \
            if (wave == 4 && n_ + 4 < 128) { while (fl_ == 0u) { __builtin_amdgcn_s_sleep(1); fl_ = __hip_atomic_load(flags + SLOT(n_ + 4), __ATOMIC_RELAXED, __HIP_MEMORY_SCOPE_AGENT); } \
                __builtin_amdgcn_fence(__ATOMIC_ACQUIRE, "agent"); glv = GLg[SLOT(n_ + 4)]; }     \
            if (n_ + 1 < 128) { SC_STORE(R, (n_ + 1) & 1); asm volatile("" ::: "memory"); if (n_ + 3 < 128) SC_LOAD(R, n_ + 3); } \
            if (n_ >= 1) { \
                float ss = 0.f; \
                _Pragma("unroll") for (int i = 0; i < 4; ++i) { const float a0 = bflo(ov[i].x), a1 = bfhi(ov[i].x), a2 = bflo(ov[i].y), a3 = bfhi(ov[i].y), a4 = bflo(ov[i].z), a5 = bfhi(ov[i].z), a6 = bflo(ov[i].w), a7 = bfhi(ov[i].w); \
                    ss += (a0 * a0 + a1 * a1) + (a2 * a2 + a3 * a3) + (a4 * a4 + a5 * a5) + (a6 * a6 + a7 * a7); } \
                ss += __shfl_xor(ss, 1); ss += __shfl_xor(ss, 2); \
                const float rstd = rsqrtf(ss * (1.f / 128.f) + RMS_EPS); \
                _Pragma("unroll") for (int i = 0; i < 4; ++i) { const v4f n0 = *(const LAS v4f*)(nwl + 32 * q + 8 * i), n1 = *(const LAS v4f*)(nwl + 32 * q + 8 * i + 4); \
                    v4u y; \
                    y.x = pk2(bflo(ov[i].x) * rstd * n0.x, bfhi(ov[i].x) * rstd * n0.y); y.y = pk2(bflo(ov[i].y) * rstd * n0.z, bfhi(ov[i].y) * rstd * n0.w); \
                    y.z = pk2(bflo(ov[i].z) * rstd * n1.x, bfhi(ov[i].z) * rstd * n1.y); y.w = pk2(bflo(ov[i].w) * rstd * n1.z, bfhi(ov[i].w) * rstd * n1.w); \
                    *(v4u*)((char*)yb_ + (yoff + 16u * i)) = y; asm volatile("" ::: "memory"); } \
            } \
            if (n_ < 128) LDS_BARRIER();                               \
        } while (0)
#pragma unroll 1
        for (int n = 0; n < 128; n += 2) { SC_LITER(n, RA); SC_LITER(n + 1, RB); }
        SC_LITER(128, RA);
#undef SC_LOAD
#undef SC_STORE
#undef SC_LITER
#undef SLOT
    }
}

#define XB_TMO      128
#define XB_XCNT(j)  (256  + 64 * (j))
#define XB_XSUB(j)  (1280 + 64 * (j))
#define XB_XGEN(j)  (2304 + 64 * (j))
#define XB_TOP      3328
#define XB_TOPGEN   3392
#define XCD_BAR_WORDS 3456
#define XB_SPIN_CAP (1u << 18)

__device__ __forceinline__ unsigned xb_ld(unsigned* p)              { return __hip_atomic_load(p, __ATOMIC_RELAXED, __HIP_MEMORY_SCOPE_AGENT); }
__device__ __forceinline__ unsigned xb_add(unsigned* p, unsigned v) { return __hip_atomic_fetch_add(p, v, __ATOMIC_RELAXED, __HIP_MEMORY_SCOPE_AGENT); }
__device__ __forceinline__ unsigned xb_xcc_id() { return (unsigned)__builtin_amdgcn_s_getreg((3 << 11) | 20) & 0xFu; }
#define XB_SPIN(cond, bar) do { unsigned _sp = 0; while (cond) { __builtin_amdgcn_s_sleep(1); \
    if ((++_sp & 255u) == 0u) { if (xb_ld(&(bar)[XB_TMO])) break; if (_sp > XB_SPIN_CAP) { atomicAdd(&(bar)[XB_TMO], 1u); break; } } } } while (0)

struct XcdBarrier {
    unsigned* bar; unsigned x;
    volatile LAS unsigned* st;
};

__device__ __forceinline__ XcdBarrier xcd_barrier_post(unsigned* bar, volatile LAS unsigned* st) {
    XcdBarrier b; b.bar = bar; b.x = xb_xcc_id(); b.st = st;
    if (threadIdx.x == 0) (void)xb_add(&bar[XB_XCNT(b.x)], 1u);
    return b;
}
__device__ __forceinline__ void xcd_barrier_complete(unsigned* bar, unsigned x, unsigned& nloc, unsigned& nx) {
    const unsigned G = gridDim.x * gridDim.y * gridDim.z;
    unsigned sum, cnt, mine, sp = 0u;
    for (;;) {
        sum = 0u; cnt = 0u; mine = 0u;
#pragma unroll
        for (unsigned j = 0; j < 16; ++j) { const unsigned c = xb_ld(&bar[XB_XCNT(j)]); sum += c; cnt += (c > 0u) ? 1u : 0u; mine = (j == x) ? c : mine; }
        if (sum == G) break;
        __builtin_amdgcn_s_sleep(1);
        if ((++sp & 255u) == 0u) { if (xb_ld(&bar[XB_TMO])) break; if (sp > XB_SPIN_CAP) { atomicAdd(&bar[XB_TMO], 1u); break; } }
    }
    nloc = mine > 0u ? mine : 1u; nx = cnt > 0u ? cnt : 1u;
}

__device__ __forceinline__ void xcd_barrier(const XcdBarrier& b) {
    asm volatile("s_waitcnt vmcnt(0)" ::: "memory");
    __syncthreads();
    if (threadIdx.x == 0) {
        unsigned* bar = b.bar;
        __builtin_amdgcn_s_waitcnt(0);
        unsigned nloc = b.st[0], nx = b.st[1];
        if (nloc == 0u) { xcd_barrier_complete(bar, b.x, nloc, nx); b.st[0] = nloc; b.st[1] = nx; }
        const unsigned old = xb_add(&bar[XB_XSUB(b.x)], 1u);
        const unsigned gen = old / nloc;
        if (old + 1u == (gen + 1u) * nloc) {
            __builtin_amdgcn_fence(__ATOMIC_RELEASE, "agent");
            asm volatile("s_waitcnt vmcnt(0)" ::: "memory");
            const unsigned og = xb_add(&bar[XB_TOP], 1u);
            const unsigned tg = og / nx;
            if (og + 1u == (tg + 1u) * nx) xb_add(&bar[XB_TOPGEN], 1u);
            else XB_SPIN(xb_ld(&bar[XB_TOPGEN]) == tg, bar);
            __builtin_amdgcn_fence(__ATOMIC_ACQUIRE, "agent");
            xb_add(&bar[XB_XGEN(b.x)], 1u);
            asm volatile("s_waitcnt vmcnt(0)" ::: "memory");
        } else {
            XB_SPIN(xb_ld(&bar[XB_XGEN(b.x)]) == gen, bar);
            __builtin_amdgcn_fence(__ATOMIC_ACQUIRE, "agent");
            asm volatile("s_waitcnt vmcnt(0)" ::: "memory");
        }
    }
    __syncthreads();
}
__device__ __forceinline__ void group_barrier(unsigned* cnt, unsigned nwg) {
    asm volatile("s_waitcnt vmcnt(0)" ::: "memory");
    __syncthreads();
    if (threadIdx.x == 0) {
        __builtin_amdgcn_fence(__ATOMIC_RELEASE, "agent");
        asm volatile("s_waitcnt vmcnt(0)" ::: "memory");
        __hip_atomic_fetch_add(cnt, 1u, __ATOMIC_RELAXED, __HIP_MEMORY_SCOPE_AGENT);
        while (__hip_atomic_load(cnt, __ATOMIC_RELAXED, __HIP_MEMORY_SCOPE_AGENT) < nwg) __builtin_amdgcn_s_sleep(2);
        __builtin_amdgcn_fence(__ATOMIC_ACQUIRE, "agent");
        asm volatile("s_waitcnt vmcnt(0)" ::: "memory");
    }
    __syncthreads();
}
struct Args { const float* in[19]; float* out; unsigned char* ws; };
__device__ __forceinline__ int tid_() { int t = threadIdx.x; asm volatile("" : "+v"(t)); return t; }
__global__ void __launch_bounds__(512, 2) fwd_megakernel(Args args) {
    extern __shared__ __attribute__((aligned(16))) unsigned char lds_raw[];
    cooperative_groups::grid_group grid = cooperative_groups::this_grid();
    LAS unsigned char* lds = (LAS unsigned char*)lds_raw;
    volatile LAS unsigned* xb_st = (volatile LAS unsigned*)(lds + LDS_BYTES - 16);
    if (threadIdx.x == 0) { xb_st[0] = 0u; xb_st[1] = 0u; }
    __syncthreads();
    const int G = gridDim.x, blk = blockIdx.x;
#define PHASE_IDS() const int tid = tid_(), lane = tid & 63, wave = __builtin_amdgcn_readfirstlane(tid >> 6), gw = blk * 8 + wave, NGW = G * 8; (void)lane; (void)gw; (void)NGW
    unsigned char* ws = args.ws;
    const float* x = args.in[0]; const float* mem = args.in[1]; const float* g_mix = args.in[2]; const float* w_in = args.in[3]; const float* sinks = args.in[4];
    const float* conv_w = args.in[5]; const float* a_log = args.in[6]; const float* dt_bias = args.in[7]; const float* gdn_norm_w = args.in[8]; const float* g_mem = args.in[9];
    const float* w_mem_kv = args.in[10]; const float* w_swa_up = args.in[11]; const float* w_gdn_up = args.in[12]; const float* w_xa_up = args.in[13]; const float* w_out = args.in[14];
    const float* g_mlp = args.in[15]; const float* w_mlp_in = args.in[16]; const float* w_mlp_out = args.in[17]; const float* g_final = args.in[18];
    float* out = args.out;
    float* ssq1 = (float*)(ws + WS_SSQ1); float* ssq2 = (float*)(ws + WS_SSQ2); float* AB = (float*)(ws + WS_AB); float* GL = (float*)(ws + WS_GL);
    bf16* MKV = (bf16*)(ws + WS_MKV); bf16* MEMN = (bf16*)(ws + WS_MEMN);
    bf16* WINT = (bf16*)(ws + WS_WINT); bf16* WMKVT = (bf16*)(ws + WS_WMKVT); bf16* WSWAT = (bf16*)(ws + WS_WSWAT); bf16* WGDNT = (bf16*)(ws + WS_WGDNT); bf16* WXAT = (bf16*)(ws + WS_WXAT); bf16* WOUTT = (bf16*)(ws + WS_WOUTT);
    bf16* P = (bf16*)(ws + WS_P); bf16* MERGED = (bf16*)(ws + WS_MERGED); bf16* HB = (bf16*)(ws + WS_HB);
    bf16* GW = (bf16*)(ws + WS_GW); bf16* GQD = (bf16*)(ws + WS_GQD); bf16* GKDT = (bf16*)(ws + WS_GKDT); bf16* GQK = (bf16*)(ws + WS_GQK); float* GU = (float*)(ws + WS_GU);
    bf16* W1T = (bf16*)(ws + WS_W1T); bf16* HMID = (bf16*)(ws + WS_HMID); bf16* W2T = (bf16*)out;
    bf16* XN = (bf16*)out; bf16* YA = (bf16*)((unsigned char*)out + 64 * MiB); bf16* YB = (bf16*)((unsigned char*)out + 96 * MiB); bf16* YC = (bf16*)((unsigned char*)out + 112 * MiB);

    for (int rep_ = 0; rep_ < REP_P0; ++rep_) {
        PHASE_IDS();
        LDS_BARRIER();
        for (int i = blk * 512 + tid; i < 2 * MTOK; i += G * 512) ssq1[i] = 0.f;
        if (blk == 0) for (int i = tid; i < 4096 + 1024; i += 512) ((unsigned*)(ws + WS_CNT))[i] = 0u;
        if (blk == 1) for (int i = tid; i < XCD_BAR_WORDS; i += 512) ((unsigned*)(ws + WS_CNT + 65536))[i] = 0u;
        LAS float* wabt = (LAS float*)(lds + 8 * 8448);
#pragma unroll
        for (int it = 0; it < 32; ++it) { const int idx = tid + 512 * it, k = idx >> 3, j = idx & 7; wabt[j * DM + k] = w_in[(size_t)k * INW + O_AB + j]; }
        LAS float* scr = (LAS float*)(lds + wave * 8448);
        int off = 0;
        transpose_matrix(w_in, INW, DM, N1, true, nullptr, WINT, scr, gw, NGW, off, lane);
        transpose_matrix(w_mem_kv, 1024, DM, 1024, false, nullptr, WMKVT, scr, gw, NGW, off, lane);
        LDS_BARRIER();
        rms_rows(x, g_mix, XN, wabt, AB, gw, NGW, MTOK, lane);
        rms_rows(mem, g_mem, MEMN, nullptr, nullptr, gw, NGW, BATCH * NMEM, lane);
    }
    grid.sync();
    const XcdBarrier xb = xcd_barrier_post((unsigned*)(ws + WS_CNT + 65536), xb_st);
    { pg8::Gemm g{XN, WINT, MTOK, NA, DM}; pg8::StaticOrder S; S.init(MTOK, NA, G, blk); pg8::EpiStore E{P, N1};
      pg8::gemm_phase<pg8::EpiStore, pg8::StaticOrder, PG8_ALIGN, PG8_SP2>(lds, g, S, E); }
    xcd_barrier(xb);
    unsigned* const flags = (unsigned*)(ws + WS_CNT) + 4096;
    unsigned* const mkv_cnt = (unsigned*)(ws + WS_CNT) + 64 * 8;
    if (blk < 8) { PHASE_IDS(); gdn_scan(blk, P, YB, gdn_norm_w, GW, GQD, GKDT, GQK, (bf16*)GU, GL, flags, lds, tid); }
    else {
        if (blk >= G - 8) {
            pg8::Gemm g{MEMN, WMKVT, BATCH * NMEM, 1024, DM}; pg8::StaticOrder S; S.init(BATCH * NMEM, 1024, G, G - 1 - blk); pg8::EpiStore E{MKV, 1024};
            pg8::gemm_phase<pg8::EpiStore, pg8::StaticOrder, PG8_ALIGN, PG8_SP2>(lds, g, S, E);
            wg_publish_add(mkv_cnt);
        }
        const int uplim = (blk >= G - 8) ? 1024 - 32 - (G - 8) : 1024 - 32;
        for (int up = blk - 8; up < uplim; up += G - 8) { PHASE_IDS(); const int uidx = (up & 7) * 128 + (up >> 3);
            gdn_prep_unit(uidx, P, AB, conv_w, a_log, dt_bias, GW, GQD, GKDT, GQK, (bf16*)GU, GL, lds, tid);
            wg_publish_add(flags + up); }
        { pg8::Gemm g{XN, WINT + (size_t)NA * DM, MTOK, N1 - NA, DM}; pg8::StaticOrder S; S.init(MTOK, N1 - NA, G - 8, blk - 8); pg8::EpiStore E{P + NA, N1};
          pg8::gemm_phase<pg8::EpiStore, pg8::StaticOrder, PG8_ALIGN, PG8_SP2>(lds, g, S, E); }
        group_barrier((unsigned*)(ws + WS_CNT) + 64 * 9, (unsigned)(G - 8));
        { PHASE_IDS();
          if (wave == 0) wave_wait_ge(mkv_cnt, 8u);
          __syncthreads();
          for (int it = (G - 1) - blk; it < 512; it += G - 8) { if (it < 256) swa_unit(it, P, YA, sinks, lds, tid); else xa_unit(it - 256, P, MKV, YC, lds, tid); }
        }
        if (blk - 8 >= 32 && blk - 8 < 72) { PHASE_IDS(); const int cw_ = blk - 8, up = (cw_ < 64) ? 1024 - 32 + (cw_ - 32) : 1024 - 32 - (G - 8) + (G - 16) + (cw_ - 64), uidx = (up & 7) * 128 + (up >> 3);
            gdn_prep_unit(uidx, P, AB, conv_w, a_log, dt_bias, GW, GQD, GKDT, GQK, (bf16*)GU, GL, lds, tid);
            wg_publish_add(flags + up); }
        { PHASE_IDS();
          LAS float* scr = (LAS float*)(lds + wave * 8448); int off = 0;
          const int cw_ = blk - 8;
          if (cw_ < 32 || cw_ >= 72) { const int gw2 = (cw_ < 32 ? cw_ : cw_ - 40) * 8 + wave, ngw2 = (G - 48) * 8;
              transpose_matrix(w_mlp_in, DFF, DM, DFF, false, g_mlp, W1T, scr, gw2, ngw2, off, lane);
              transpose_matrix(w_mlp_out, DM, DFF, DM, false, nullptr, W2T, scr, gw2, ngw2, off, lane);
              transpose_matrix(w_swa_up, DM, 1024, DM, false, nullptr, WSWAT, scr, gw2, ngw2, off, lane);
              transpose_matrix(w_gdn_up, DM, 512, DM, false, nullptr, WGDNT, scr, gw2, ngw2, off, lane);
              transpose_matrix(w_xa_up, DM, 512, DM, false, nullptr, WXAT, scr, gw2, ngw2, off, lane);
              transpose_matrix(w_out, DM, DM, DM, false, nullptr, WOUTT, scr, gw2, ngw2, off, lane); }
          LDS_BARRIER(); }
    }
    xcd_barrier(xb);
    { PHASE_IDS();
      for (int e = blk * 512 + tid; e < MTOK * 64; e += G * 512) { const int tok = e >> 6, c8 = (e & 63) * 8;
          v4u y = *(const v4u*)(YB + (size_t)tok * 512 + c8); const v4u z = *(const v4u*)(P + (size_t)tok * N1 + C_ZB + c8);
          const float z0 = bflo(z.x), z1 = bfhi(z.x), z2 = bflo(z.y), z3 = bfhi(z.y), z4 = bflo(z.z), z5 = bfhi(z.z), z6 = bflo(z.w), z7 = bfhi(z.w);
          y.x = pk2(bflo(y.x) * (z0 * sigmoidf_(z0)), bfhi(y.x) * (z1 * sigmoidf_(z1))); y.y = pk2(bflo(y.y) * (z2 * sigmoidf_(z2)), bfhi(y.y) * (z3 * sigmoidf_(z3)));
          y.z = pk2(bflo(y.z) * (z4 * sigmoidf_(z4)), bfhi(y.z) * (z5 * sigmoidf_(z5))); y.w = pk2(bflo(y.w) * (z6 * sigmoidf_(z6)), bfhi(y.w) * (z7 * sigmoidf_(z7)));
          *(v4u*)(YB + (size_t)tok * 512 + c8) = y; }
    }
    { pg8::StaticOrder S; S.init(MTOK, DM, G, blk);
      { pg8::Gemm g{YA, WSWAT, MTOK, DM, 1024}; pg8::EpiGate E{P + C_GATE, N1, MERGED, DM, 1}; pg8::gemm_phase<pg8::EpiGate, pg8::StaticOrder, PG8_ALIGN, PG8_SP2>(lds, g, S, E); }
      { pg8::Gemm g{YC, WXAT, MTOK, DM, 512}; pg8::EpiGate E{P + C_GATE + 2 * DM, N1, MERGED, DM, 0}; pg8::gemm_phase<pg8::EpiGate, pg8::StaticOrder, PG8_ALIGN, PG8_SP2>(lds, g, S, E); }
      xcd_barrier(xb);
      { pg8::Gemm g{YB, WGDNT, MTOK, DM, 512}; pg8::EpiGate E{P + C_GATE + DM, N1, MERGED, DM, 0}; pg8::gemm_phase<pg8::EpiGate, pg8::StaticOrder, PG8_ALIGN, PG8_SP2>(lds, g, S, E); } }
    xcd_barrier(xb);
    {
        PHASE_IDS();
        LAS float* scr = (LAS float*)(lds + wave * 8448);
        int off = 0;
        LDS_BARRIER();
        pg8::Gemm g{MERGED, WOUTT, MTOK, DM, DM}; pg8::StaticOrder S; S.init(MTOK, DM, G, blk); pg8::EpiResid E{x, nullptr, nullptr, HB, ssq1, DM};
        pg8::gemm_phase<pg8::EpiResid, pg8::StaticOrder, PG8_ALIGN, PG8_SP2>(lds, g, S, E);
    }
    xcd_barrier(xb);
    { pg8::Gemm g{HB, W1T, MTOK, DFF, DM}; pg8::StaticOrder S; S.init(MTOK, DFF, G, blk); pg8::EpiRelu2 E{HMID, DFF, ssq1, 1.f / DM, RMS_EPS};
      pg8::gemm_phase<pg8::EpiRelu2, pg8::StaticOrder, PG8_ALIGN, PG8_SP2>(lds, g, S, E); }
    xcd_barrier(xb);
    { pg8::Gemm g{HMID, W2T, MTOK, DM, DFF}; pg8::StaticOrder S; S.init(MTOK, DM, G, blk); pg8::EpiResid E{nullptr, HB, nullptr, HB, ssq2, DM};
      pg8::gemm_phase<pg8::EpiResid, pg8::StaticOrder, PG8_ALIGN, PG8_SP2>(lds, g, S, E); }
    xcd_barrier(xb);
    { PHASE_IDS();
    for (int m = gw; m < MTOK; m += NGW) {
        const float rstd = rsqrtf(ssq2[m] * (1.f / DM) + RMS_EPS);
        const v4u* h4 = (const v4u*)(HB + (size_t)m * DM) + lane; v4f* o4 = (v4f*)(out + (size_t)m * DM) + 2 * lane; const v4f* g4 = (const v4f*)g_final + 2 * lane;
#pragma unroll
        for (int j = 0; j < 4; ++j) { const v4u w = h4[64 * j]; const v4f ga = g4[128 * j], gb = g4[128 * j + 1];
            o4[128 * j] = (v4f){bflo(w.x), bfhi(w.x), bflo(w.y), bfhi(w.y)} * rstd * ga; o4[128 * j + 1] = (v4f){bflo(w.z), bfhi(w.z), bflo(w.w), bfhi(w.w)} * rstd * gb; }
    } }
}

extern "C" void kernel_launch(void* const* d_in, const int* in_sizes, int n_in, void* d_out, int out_size, void* d_ws, size_t ws_size, hipStream_t stream) {
    static int grid = 0;
    if (grid == 0) {
        if (n_in != 19 || in_sizes[0] != MTOK * DM || out_size != MTOK * DM || ws_size < WS_END) {
            fprintf(stderr, "kernel_launch: unexpected problem (n_in %d, in0 %d, out %d, ws %zu; need ws >= %zu); nothing launched\n", n_in, n_in > 0 ? in_sizes[0] : -1, out_size, ws_size, (size_t)WS_END); grid = -1; return; }
        int dev = 0, cus = 0, per_cu = 0;
        if (hipGetDevice(&dev) != hipSuccess || hipDeviceGetAttribute(&cus, hipDeviceAttributeMultiprocessorCount, dev) != hipSuccess) { fprintf(stderr, "kernel_launch: device query failed\n"); grid = -1; return; }
        if (hipFuncSetAttribute((const void*)fwd_megakernel, hipFuncAttributeMaxDynamicSharedMemorySize, LDS_BYTES) != hipSuccess) { fprintf(stderr, "kernel_launch: hipFuncSetAttribute failed\n"); grid = -1; return; }
        if (hipOccupancyMaxActiveBlocksPerMultiprocessor(&per_cu, (const void*)fwd_megakernel, 512, LDS_BYTES) != hipSuccess || per_cu < 1) { fprintf(stderr, "kernel_launch: occupancy query says %d blocks per CU\n", per_cu); per_cu = 1; }
        (void)hipGetLastError();
        grid = cus;
    }
    if (grid < 0) return;
    Args a{};
    for (int i = 0; i < 19; ++i) a.in[i] = (const float*)d_in[i];
    a.out = (float*)d_out; a.ws = (unsigned char*)d_ws;
    void* kargs[] = {&a};
    const hipError_t e = hipLaunchCooperativeKernel((const void*)fwd_megakernel, dim3(grid), dim3(512), kargs, LDS_BYTES, stream);
    if (e != hipSuccess) fprintf(stderr, "kernel_launch: cooperative launch failed: %s (grid %d)\n", hipGetErrorString(e), grid);
}
```
